# Optimizing an MI355X kernel written in HIP

```python
import math
import jax, jax.numpy as jnp
from jax import lax
import numpy as np

D_MODEL = 2048
BATCH = 1
SEQ = 8192
DEPTH = 2

F32 = jnp.float32
N_BRANCH = 4
BRANCH_WIDTH = D_MODEL // N_BRANCH
NORM_EPS = 1e-6
GN_EPS = 1e-5
ROPE_BASE = 10000.0
LRU_WIDTH = BRANCH_WIDTH
LRU_BLOCKS = 8
LRU_BLOCK_DIM = LRU_WIDTH // LRU_BLOCKS
CONV_WIDTH = 4
LRU_C = 8.0
MLA_HEADS = 4
MLA_NOPE_DIM = 128
MLA_ROPE_DIM = 64
MLA_V_DIM = 128
MLA_QK_DIM = MLA_NOPE_DIM + MLA_ROPE_DIM
MLA_Q_LORA = 384
MLA_KV_LORA = 256
Q_BLOCK = 128
RET_HEADS = 4
RET_HEAD_DIM = BRANCH_WIDTH // RET_HEADS
RET_WIDTH = RET_HEADS * RET_HEAD_DIM
RET_CHUNK = 128
RWKV_HEAD_DIM = 64
RWKV_HEADS = BRANCH_WIDTH // RWKV_HEAD_DIM
RWKV_WIDTH = RWKV_HEADS * RWKV_HEAD_DIM
RWKV_DECAY_LORA = 64
RWKV_AAA_LORA = 64
RWKV_GATE_LORA = 128
RWKV_COLS = 3 * RWKV_WIDTH + RWKV_DECAY_LORA + RWKV_AAA_LORA + RWKV_GATE_LORA
FFN_HIDDEN = -(-8 * D_MODEL // (3 * 256)) * 256
GATE_COLS = N_BRANCH * D_MODEL
IN_SPLITS = (GATE_COLS, LRU_WIDTH, LRU_WIDTH, MLA_Q_LORA, MLA_KV_LORA, MLA_ROPE_DIM,
             4 * RET_WIDTH, RWKV_COLS)
N_IN = sum(IN_SPLITS)

kernel_name = 'hybrid_lru_mla_retnet_rwkv7_adaln_block'


def split_cols(p, sizes):
    idx = np.cumsum(sizes)[:-1].tolist()
    return jnp.split(p, idx, axis=-1)


def rms_norm(x, g, eps=NORM_EPS):
    xf = x.astype(F32)
    y = xf * lax.rsqrt(jnp.mean(xf * xf, axis=-1, keepdims=True) + eps)
    return (y * g.astype(F32)).astype(x.dtype)


def head_group_norm(x, gain, eps=GN_EPS):
    xf = x.astype(F32)
    xc = xf - jnp.mean(xf, axis=-1, keepdims=True)
    return xc * lax.rsqrt(jnp.mean(xc * xc, axis=-1, keepdims=True) + eps) * gain.astype(F32)


def rope_tables(positions, dim):
    inv = 1.0 / (ROPE_BASE ** (jnp.arange(0, dim, 2, dtype=F32) / dim))
    ang = positions.astype(F32)[..., None] * inv
    return jnp.cos(ang), jnp.sin(ang)


def apply_rope(x, cos, sin):
    x1, x2 = jnp.split(x, 2, axis=-1)
    c = cos[:, :, None, :]
    s = sin[:, :, None, :]
    return jnp.concatenate([x1 * c - x2 * s, x1 * s + x2 * c], axis=-1).astype(x.dtype)


def causal_depthwise_conv(x, w, b):
    y = lax.conv_general_dilated(
        x, w[:, None, :].astype(x.dtype), window_strides=(1,),
        padding=[(CONV_WIDTH - 1, 0)], dimension_numbers=('NWC', 'WIO', 'NWC'),
        feature_group_count=x.shape[-1])
    return y + b.astype(x.dtype)


def rg_lru(x, wr, br, wi, bi, lam):
    B, T, _ = x.shape
    xf = x.astype(F32)
    xb = xf.reshape(B, T, LRU_BLOCKS, LRU_BLOCK_DIM)
    r = jax.nn.sigmoid(jnp.einsum('btni,nij->btnj', xb, wr.astype(F32)).reshape(B, T, LRU_WIDTH) + br)
    i = jax.nn.sigmoid(jnp.einsum('btni,nij->btnj', xb, wi.astype(F32)).reshape(B, T, LRU_WIDTH) + bi)
    log_a = -LRU_C * jax.nn.softplus(-lam.astype(F32)) * r
    a = jnp.exp(log_a)
    u = jnp.sqrt(-jnp.expm1(2.0 * log_a)) * (i * xf)

    def combine(left, right):
        a1, u1 = left
        a2, u2 = right
        return a1 * a2, a2 * u1 + u2

    _, h = lax.associative_scan(combine, (a, u), axis=1)
    return h


def causal_block_attention(q, k, v, scale):
    B, T, H, Dk = q.shape
    n_blk = T // Q_BLOCK
    qb = jnp.moveaxis(q.reshape(B, n_blk, Q_BLOCK, H, Dk), 1, 0)
    kpos = jnp.arange(T)

    def one_block(args):
        qi, bi = args
        s = jnp.einsum('bqhd,bkhd->bhqk', qi, k, preferred_element_type=F32) * scale
        qpos = bi * Q_BLOCK + jnp.arange(Q_BLOCK)
        s = jnp.where(kpos[None, :] <= qpos[:, None], s, -jnp.inf)
        p = jax.nn.softmax(s, axis=-1)
        return jnp.einsum('bhqk,bkhd->bqhd', p.astype(v.dtype), v)

    o = lax.map(one_block, (qb, jnp.arange(n_blk)))
    return jnp.moveaxis(o, 0, 1).reshape(B, T, H, v.shape[-1])


def mla_branch(cq, ckv, k_rope, cos, sin, g_cq, g_ckv, w_uq, w_ukv, g_qn, g_kn):
    B, T, _ = cq.shape
    q = (rms_norm(cq, g_cq) @ w_uq).reshape(B, T, MLA_HEADS, MLA_QK_DIM)
    kv = (rms_norm(ckv, g_ckv) @ w_ukv).reshape(B, T, MLA_HEADS, MLA_NOPE_DIM + MLA_V_DIM)
    k_nope, v = jnp.split(kv, [MLA_NOPE_DIM], axis=-1)
    k_r = jnp.broadcast_to(k_rope[:, :, None, :], (B, T, MLA_HEADS, MLA_ROPE_DIM)).astype(k_nope.dtype)
    k = jnp.concatenate([k_nope, k_r], axis=-1)
    q = rms_norm(q, g_qn)
    k = rms_norm(k, g_kn)
    q = jnp.concatenate([q[..., :MLA_NOPE_DIM], apply_rope(q[..., MLA_NOPE_DIM:], cos, sin)], axis=-1)
    k = jnp.concatenate([k[..., :MLA_NOPE_DIM], apply_rope(k[..., MLA_NOPE_DIM:], cos, sin)], axis=-1)
    o = causal_block_attention(q, k, v, MLA_QK_DIM ** -0.5)
    return o.reshape(B, T, MLA_HEADS * MLA_V_DIM)


def retention_branch(ret_p, cos, sin, g_norm):
    B, T, _ = ret_p.shape
    H, Dh, C = RET_HEADS, RET_HEAD_DIM, RET_CHUNK
    q, k, v, g = jnp.split(ret_p, 4, axis=-1)
    q = apply_rope(q.reshape(B, T, H, Dh), cos, sin).astype(F32)
    k = apply_rope(k.reshape(B, T, H, Dh), cos, sin).astype(F32) * (Dh ** -0.5)
    v = v.reshape(B, T, H, Dh).astype(F32)
    log_gamma = jnp.log1p(-jnp.exp(jnp.linspace(math.log(1.0 / 32), math.log(1.0 / 512), H, dtype=F32)))
    idx = jnp.arange(C, dtype=F32)
    rel = idx[:, None] - idx[None, :]
    decay_in = jnp.where(rel >= 0, jnp.exp(log_gamma[:, None, None] * jnp.maximum(rel, 0.0)), 0.0)
    q_dec = jnp.exp(log_gamma[:, None] * (idx + 1.0))[None, :, :, None]
    k_dec = jnp.exp(log_gamma[:, None] * (C - 1.0 - idx))[None, :, :, None]
    chunk_dec = jnp.exp(log_gamma * C)[None, :, None, None]
    n = T // C

    def to_chunks(t):
        return t.reshape(B, n, C, H, Dh).transpose(1, 0, 3, 2, 4)

    def step(state, inp):
        qi, ki, vi = inp
        inner = jnp.einsum('bhqd,bhkd->bhqk', qi, ki) * decay_in
        o = jnp.einsum('bhqk,bhkv->bhqv', inner, vi) + jnp.einsum('bhqd,bhdv->bhqv', qi * q_dec, state)
        state = chunk_dec * state + jnp.einsum('bhkd,bhkv->bhdv', ki * k_dec, vi)
        return state, o

    state0 = jnp.zeros((B, H, Dh, Dh), F32)
    _, o = lax.scan(step, state0, (to_chunks(q), to_chunks(k), to_chunks(v)))
    o = o.transpose(1, 0, 3, 2, 4).reshape(B, T, H, Dh)
    o = head_group_norm(o, g_norm.reshape(H, Dh)).reshape(B, T, H * Dh)
    return jax.nn.silu(g.astype(F32)) * o


def rwkv7_branch(p, mu, w0, w_up, a0, a_up, g_up, k_k, k_a, r_k, g_norm):
    B, T, _ = p.shape
    H, N = RWKV_HEADS, RWKV_HEAD_DIM
    pf = p.astype(F32)
    prev = jnp.pad(pf, ((0, 0), (1, 0), (0, 0)))[:, :-1]
    xs = pf + (prev - pf) * mu.astype(F32)
    r, k, v, wd, ad, gd = split_cols(xs, (RWKV_WIDTH, RWKV_WIDTH, RWKV_WIDTH,
                                          RWKV_DECAY_LORA, RWKV_AAA_LORA, RWKV_GATE_LORA))
    w_log = -jax.nn.softplus(-(w0 + jnp.tanh(wd) @ w_up)) - 0.5
    decay = jnp.exp(-jnp.exp(w_log))
    a = jax.nn.sigmoid(a0 + ad @ a_up)
    g = jax.nn.sigmoid(gd) @ g_up

    def heads(t):
        return t.reshape(B, T, H, N).astype(F32)

    kk = heads(k * k_k)
    kk = kk / jnp.maximum(jnp.sqrt(jnp.sum(kk * kk, axis=-1, keepdims=True)), 1e-12)
    k = heads(k * (1.0 + (a - 1.0) * k_a))
    r, v, w, a = heads(r), heads(v), heads(decay), heads(a)

    def step(S, inp):
        r_t, w_t, k_t, v_t, neg_kk_t, akk_t = inp
        sa = jnp.einsum('bhvk,bhk->bhv', S, neg_kk_t)
        S = S * w_t[:, :, None, :] + sa[..., None] * akk_t[:, :, None, :] + v_t[..., None] * k_t[:, :, None, :]
        return S, jnp.einsum('bhvk,bhk->bhv', S, r_t)

    def tm(t):
        return jnp.moveaxis(t, 1, 0)

    S0 = jnp.zeros((B, H, N, N), F32)
    _, o = lax.scan(step, S0, (tm(r), tm(w), tm(k), tm(v), tm(-kk), tm(kk * a)))
    o = jnp.moveaxis(o, 0, 1)
    o = head_group_norm(o, g_norm.reshape(H, N))
    o = o + jnp.sum(r * k * r_k.reshape(H, N).astype(F32), axis=-1, keepdims=True) * v
    return o.reshape(B, T, H * N) * g


def setup_inputs(seed: int = 0) -> dict:
    key = jax.random.key(seed)
    ks = list(jax.random.split(key, 40))
    L = DEPTH

    def nrm(i, shape, scale):
        return jax.random.normal(ks[i], shape, F32) * scale

    def unif(i, shape, lo, hi):
        return jax.random.uniform(ks[i], shape, F32, lo, hi)

    x = nrm(0, (BATCH, SEQ, D_MODEL), 1.0)
    c = nrm(1, (BATCH, D_MODEL), 1.0)
    start = jax.random.randint(ks[2], (BATCH, 1), 0, 4096, dtype=jnp.int32)
    positions = (start + jnp.arange(SEQ, dtype=jnp.int32)[None, :]).astype(jnp.int32)
    u = unif(14, (L, LRU_WIDTH), 0.9, 0.999)
    log_a = jnp.log(u) / LRU_C
    lru_lam = log_a - jnp.log(-jnp.expm1(log_a))
    return {
        'x': x, 'c': c, 'positions': positions,
        'ada_w': nrm(3, (L, D_MODEL, 6 * D_MODEL), 0.25 * D_MODEL ** -0.5),
        'ada_b': nrm(4, (L, 6 * D_MODEL), 0.02),
        'norm_mix': 1.0 + nrm(5, (L, D_MODEL), 0.02),
        'norm_ffn': 1.0 + nrm(6, (L, D_MODEL), 0.02),
        'w_in': nrm(7, (L, D_MODEL, N_IN), D_MODEL ** -0.5),
        'conv_w': nrm(8, (L, CONV_WIDTH, LRU_WIDTH), CONV_WIDTH ** -0.5),
        'conv_b': nrm(9, (L, LRU_WIDTH), 0.02),
        'lru_wr': nrm(10, (L, LRU_BLOCKS, LRU_BLOCK_DIM, LRU_BLOCK_DIM), LRU_BLOCK_DIM ** -0.5),
        'lru_br': nrm(11, (L, LRU_WIDTH), 0.02),
        'lru_wi': nrm(12, (L, LRU_BLOCKS, LRU_BLOCK_DIM, LRU_BLOCK_DIM), LRU_BLOCK_DIM ** -0.5),
        'lru_bi': nrm(13, (L, LRU_WIDTH), 0.02),
        'lru_lam': lru_lam,
        'mla_g_cq': 1.0 + nrm(15, (L, MLA_Q_LORA), 0.02),
        'mla_g_ckv': 1.0 + nrm(16, (L, MLA_KV_LORA), 0.02),
        'mla_w_uq': nrm(17, (L, MLA_Q_LORA, MLA_HEADS * MLA_QK_DIM), MLA_Q_LORA ** -0.5),
        'mla_w_ukv': nrm(18, (L, MLA_KV_LORA, MLA_HEADS * (MLA_NOPE_DIM + MLA_V_DIM)), MLA_KV_LORA ** -0.5),
        'mla_g_qn': 1.0 + nrm(19, (L, MLA_QK_DIM), 0.02),
        'mla_g_kn': 1.0 + nrm(20, (L, MLA_QK_DIM), 0.02),
        'ret_g_norm': 1.0 + nrm(21, (L, RET_WIDTH), 0.02),
        'rwkv_mu': unif(22, (L, RWKV_COLS), 0.0, 1.0),
        'rwkv_w0': unif(23, (L, RWKV_WIDTH), -6.5, -1.5),
        'rwkv_w_up': nrm(24, (L, RWKV_DECAY_LORA, RWKV_WIDTH), 0.1),
        'rwkv_a0': nrm(25, (L, RWKV_WIDTH), 0.1),
        'rwkv_a_up': nrm(26, (L, RWKV_AAA_LORA, RWKV_WIDTH), 0.1),
        'rwkv_g_up': nrm(27, (L, RWKV_GATE_LORA, RWKV_WIDTH), RWKV_GATE_LORA ** -0.5),
        'rwkv_k_k': 0.85 + nrm(28, (L, RWKV_WIDTH), 0.02),
        'rwkv_k_a': 1.0 + nrm(29, (L, RWKV_WIDTH), 0.02),
        'rwkv_r_k': nrm(30, (L, RWKV_WIDTH), 0.1),
        'rwkv_g_norm': 1.0 + nrm(31, (L, RWKV_WIDTH), 0.02),
        'w_branch': nrm(32, (L, N_BRANCH, BRANCH_WIDTH, D_MODEL), BRANCH_WIDTH ** -0.5),
        'w_out': nrm(33, (L, D_MODEL, D_MODEL), D_MODEL ** -0.5),
        'ffn_w_in': nrm(34, (L, D_MODEL, 2 * FFN_HIDDEN), D_MODEL ** -0.5),
        'ffn_w_out': nrm(35, (L, FFN_HIDDEN, D_MODEL), FFN_HIDDEN ** -0.5),
    }


def reference(x, c, positions, ada_w, ada_b, norm_mix, norm_ffn, w_in, conv_w, conv_b,
              lru_wr, lru_br, lru_wi, lru_bi, lru_lam, mla_g_cq, mla_g_ckv, mla_w_uq, mla_w_ukv,
              mla_g_qn, mla_g_kn, ret_g_norm, rwkv_mu, rwkv_w0, rwkv_w_up, rwkv_a0, rwkv_a_up,
              rwkv_g_up, rwkv_k_k, rwkv_k_a, rwkv_r_k, rwkv_g_norm, w_branch, w_out,
              ffn_w_in, ffn_w_out):
    B, T, _ = x.shape
    dt = x.dtype
    cos_m, sin_m = rope_tables(positions, MLA_ROPE_DIM)
    cos_r, sin_r = rope_tables(positions, RET_HEAD_DIM)
    c_act = jax.nn.silu(c)
    for l in range(DEPTH):
        mod = c_act @ ada_w[l] + ada_b[l]
        shift_m, scale_m, gate_m, shift_f, scale_f, gate_f = [m[:, None, :] for m in jnp.split(mod, 6, axis=-1)]

        h = (rms_norm(x, norm_mix[l]) * (1.0 + scale_m) + shift_m).astype(dt)
        p = h @ w_in[l]
        gate_logits, a_x, a_gate, cq, ckv, k_rope, ret_p, rwkv_p = split_cols(p, IN_SPLITS)

        xa = causal_depthwise_conv(a_x, conv_w[l], conv_b[l])
        y_a = (rg_lru(xa, lru_wr[l], lru_br[l], lru_wi[l], lru_bi[l], lru_lam[l])
               * jax.nn.gelu(a_gate.astype(F32))).astype(dt)
        y_b = mla_branch(cq, ckv, k_rope, cos_m, sin_m, mla_g_cq[l], mla_g_ckv[l], mla_w_uq[l],
                         mla_w_ukv[l], mla_g_qn[l], mla_g_kn[l]).astype(dt)
        y_c = retention_branch(ret_p, cos_r, sin_r, ret_g_norm[l]).astype(dt)
        y_d = rwkv7_branch(rwkv_p, rwkv_mu[l], rwkv_w0[l], rwkv_w_up[l], rwkv_a0[l], rwkv_a_up[l],
                           rwkv_g_up[l], rwkv_k_k[l], rwkv_k_a[l], rwkv_r_k[l], rwkv_g_norm[l]).astype(dt)

        ys = jnp.stack([y_a, y_b, y_c, y_d], axis=2)
        branch = jnp.einsum('btni,nid->btnd', ys, w_branch[l])
        gates = jax.nn.sigmoid(gate_logits.astype(F32)).reshape(B, T, N_BRANCH, D_MODEL)
        merged = jnp.sum(gates * branch, axis=2).astype(dt)
        x = x + (gate_m * (merged @ w_out[l])).astype(dt)

        h2 = (rms_norm(x, norm_ffn[l]) * (1.0 + scale_f) + shift_f).astype(dt)
        u_gate, u_val = jnp.split(h2 @ ffn_w_in[l], 2, axis=-1)
        ff = (jax.nn.silu(u_gate) * u_val) @ ffn_w_out[l]
        x = x + (gate_f * ff).astype(dt)
    return x
```

```cpp
#include <hip/hip_runtime.h>
#include <hip/hip_cooperative_groups.h>
#include <cstdio>
namespace cg = cooperative_groups;

#ifndef COOP
#define COOP 1
#endif

#define LAS __attribute__((address_space(3)))
typedef unsigned short bf16_t;
typedef short bf16x8 __attribute__((ext_vector_type(8)));
typedef float f32x4 __attribute__((ext_vector_type(4)));
typedef float f32x2 __attribute__((ext_vector_type(2)));
typedef unsigned u32x4 __attribute__((ext_vector_type(4)));
typedef unsigned u32x2 __attribute__((ext_vector_type(2)));

constexpr int T = 8192, D = 2048, NIN = 13760, NINP = 13824, FF = 5632;
constexpr int PAX = 8192, PAG = 8704, PCQ = 9216, PCKV = 9600, PKR = 9856, PRET = 9920, PRW = 11968;
constexpr int NTHR = 512;
constexpr int LDS_BYTES = 131072 + 16;
constexpr int G1B_N = 46 * 256;

constexpr size_t al(size_t x) { return (x + 255) & ~(size_t)255; }
constexpr size_t O_WT_IN = 0;
constexpr size_t O_WT_FFI = O_WT_IN + al((size_t)NINP * D * 2);
constexpr size_t O_WT_FFO = O_WT_FFI + al((size_t)2 * FF * D * 2);
constexpr size_t O_WT_OUT = O_WT_FFO + al((size_t)D * FF * 2);
constexpr size_t O_WT_BR = O_WT_OUT + al((size_t)D * D * 2);
constexpr size_t O_WT_UQ = O_WT_BR + al((size_t)4 * D * 512 * 2);
constexpr size_t O_WT_UKV = O_WT_UQ + al((size_t)768 * 384 * 2);
constexpr size_t O_WT_LORA = O_WT_UKV + al((size_t)1024 * 256 * 2);
constexpr size_t O_MOD = O_WT_LORA + al((size_t)1536 * 256 * 2);
constexpr size_t O_COSM = O_MOD + al((size_t)2 * 6 * D * 4);
constexpr size_t O_SINM = O_COSM + al((size_t)T * 32 * 4);
constexpr size_t O_COSR = O_SINM + al((size_t)T * 32 * 4);
constexpr size_t O_SINR = O_COSR + al((size_t)T * 64 * 4);
constexpr size_t O_XRES = O_SINR + al((size_t)T * 64 * 4);
constexpr size_t O_HBUF = O_XRES + al((size_t)T * D * 4);
constexpr size_t O_P = O_HBUF + al((size_t)T * D * 2);
constexpr size_t O_YS = O_P + al((size_t)T * NINP * 2);
constexpr size_t O_HLOC = O_YS + al((size_t)T * D * 2);
constexpr size_t O_PC = O_HLOC + al((size_t)T * 512 * 4);
constexpr size_t O_TILEA = O_PC + al((size_t)T * 512 * 4);
constexpr size_t O_TILEH = O_TILEA + al((size_t)128 * 512 * 4);
constexpr size_t O_CARRY = O_TILEH + al((size_t)128 * 512 * 4);
constexpr size_t O_CQN = O_CARRY + al((size_t)128 * 512 * 4);
constexpr size_t O_CKVN = O_CQN + al((size_t)T * 384 * 2);
constexpr size_t O_QRAW = O_CKVN + al((size_t)T * 256 * 2);
constexpr size_t O_KVRAW = O_QRAW + al((size_t)T * 768 * 2);
constexpr size_t O_MQ = O_KVRAW + al((size_t)T * 1024 * 2);
constexpr size_t O_MK = O_MQ + al((size_t)4 * T * 192 * 2);
constexpr size_t O_MVT = O_MK + al((size_t)4 * T * 192 * 2);
constexpr size_t O_RQ = O_MVT + al((size_t)4 * 128 * T * 2);
constexpr size_t O_RK = O_RQ + al((size_t)T * 512 * 2);
constexpr size_t O_RKDT = O_RK + al((size_t)T * 512 * 2);
constexpr size_t O_RVT = O_RKDT + al((size_t)T * 512 * 2);
constexpr size_t O_RKV = O_RVT + al((size_t)T * 512 * 2);
constexpr size_t O_RSB = O_RKV + al((size_t)4 * 64 * 128 * 128 * 4);
constexpr size_t O_LORAA = O_RSB + al((size_t)4 * 64 * 128 * 128 * 2);
constexpr size_t O_LORAO = O_LORAA + al((size_t)T * 256 * 2);
constexpr size_t O_SCAN = O_LORAO + al((size_t)T * 1536 * 4);
constexpr size_t O_RWV = O_SCAN + al((size_t)T * 8 * 5 * 64 * 4);
constexpr size_t O_RWG = O_RWV + al((size_t)T * 512 * 4);
constexpr size_t O_RWS = O_RWG + al((size_t)T * 512 * 4);
constexpr size_t O_ORAW = O_RWS + al((size_t)T * 8 * 4 * 4);
constexpr size_t O_BAR = O_ORAW + al((size_t)T * 512 * 4);
constexpr size_t O_END = O_BAR + al((size_t)8192 * 4);

struct Params {
    const float* x; const float* c; const int* pos;
    const float *ada_w, *ada_b, *norm_mix, *norm_ffn, *w_in, *conv_w, *conv_b, *lru_wr, *lru_br, *lru_wi, *lru_bi, *lru_lam,
        *mla_g_cq, *mla_g_ckv, *mla_w_uq, *mla_w_ukv, *mla_g_qn, *mla_g_kn, *ret_g_norm, *rwkv_mu, *rwkv_w0, *rwkv_w_up, *rwkv_a0,
        *rwkv_a_up, *rwkv_g_up, *rwkv_k_k, *rwkv_k_a, *rwkv_r_k, *rwkv_g_norm, *w_branch, *w_out, *ffn_w_in, *ffn_w_out;
    float* out; unsigned char* ws;
};

__device__ __forceinline__ bf16_t f2bf(float f) { unsigned u = __float_as_uint(f); u += 0x7FFFu + ((u >> 16) & 1u); return (bf16_t)(u >> 16); }
__device__ __forceinline__ float bf2f(bf16_t b) { return __uint_as_float(((unsigned)b) << 16); }
__device__ __forceinline__ unsigned pack2(float lo, float hi) { unsigned r; asm("v_cvt_pk_bf16_f32 %0, %1, %2" : "=v"(r) : "v"(lo), "v"(hi)); return r; }
__device__ __forceinline__ float bflo(unsigned u) { return __uint_as_float(u << 16); }
__device__ __forceinline__ float bfhi(unsigned u) { return __uint_as_float(u & 0xFFFF0000u); }
__device__ __forceinline__ int tid_() { int t = threadIdx.x; asm volatile("" : "+v"(t)); return t; }
__device__ __forceinline__ int bid_() { int t = blockIdx.x; asm volatile("" : "+s"(t)); return t; }
__device__ const float INVF[64] = {1.000000000e+00f, 8.659643531e-01f, 7.498942018e-01f, 6.493816376e-01f, 5.623413324e-01f, 4.869675338e-01f, 4.216965139e-01f, 3.651741147e-01f, 3.162277639e-01f, 2.738419771e-01f, 2.371373922e-01f, 2.053525001e-01f, 1.778279394e-01f, 1.539926529e-01f, 1.333521456e-01f, 1.154782027e-01f, 1.000000015e-01f, 8.659642935e-02f, 7.498941571e-02f, 6.493816525e-02f, 5.623412877e-02f, 4.869675264e-02f, 4.216964915e-02f, 3.651741147e-02f, 3.162277862e-02f, 2.738419734e-02f, 2.371373586e-02f, 2.053524926e-02f, 1.778279431e-02f, 1.539926510e-02f, 1.333521493e-02f, 1.154781971e-02f, 9.999999776e-03f, 8.659643121e-03f, 7.498942316e-03f, 6.493816618e-03f, 5.623413250e-03f, 4.869675264e-03f, 4.216964822e-03f, 3.651741426e-03f, 3.162277862e-03f, 2.738419687e-03f, 2.371373819e-03f, 2.053525066e-03f, 1.778279431e-03f, 1.539926627e-03f, 1.333521446e-03f, 1.154781901e-03f, 1.000000047e-03f, 8.659643354e-04f, 7.498941850e-04f, 6.493816618e-04f, 5.623413017e-04f, 4.869675031e-04f, 4.216965463e-04f, 3.651741135e-04f, 3.162277862e-04f, 2.738419571e-04f, 2.371373848e-04f, 2.053525241e-04f, 1.778279402e-04f, 1.539926452e-04f, 1.333521504e-04f, 1.154782076e-04f};
__device__ __forceinline__ float ret_lg(int h) { return h == 0 ? -3.174869716e-02f : h == 1 ? -1.247911062e-02f : h == 2 ? -4.933717661e-03f : -1.955034910e-03f; }
__device__ __forceinline__ float sigmoidf_(float x) { return __builtin_amdgcn_rcpf(1.0f + __expf(-x)); }
__device__ __forceinline__ float ex2(float x) { return __builtin_amdgcn_exp2f(x); }
__device__ __forceinline__ void unpack8(u32x4 v, float* f) {
    f[0] = bflo(v[0]); f[1] = bfhi(v[0]); f[2] = bflo(v[1]); f[3] = bfhi(v[1]);
    f[4] = bflo(v[2]); f[5] = bfhi(v[2]); f[6] = bflo(v[3]); f[7] = bfhi(v[3]);
}
__device__ __forceinline__ u32x4 pack8(const float* f) {
    u32x4 r; r[0] = pack2(f[0], f[1]); r[1] = pack2(f[2], f[3]); r[2] = pack2(f[4], f[5]); r[3] = pack2(f[6], f[7]); return r;
}
__device__ __forceinline__ bf16x8 as_bf16x8(u32x4 v) { union { u32x4 a; bf16x8 b; } u; u.a = v; return u.b; }
template <int CTRL> __device__ __forceinline__ float dpp_f(float v) {
    return __int_as_float(__builtin_amdgcn_mov_dpp(__float_as_int(v), CTRL, 0xF, 0xF, true));
}
__device__ __forceinline__ float row16_sum(float v) {
    v += dpp_f<0xB1>(v);
    v += dpp_f<0x4E>(v);
    v += dpp_f<0x141>(v);
    v += dpp_f<0x140>(v);
    return v;
}

__device__ __forceinline__ float row8_sum(float v) { v += dpp_f<0xB1>(v); v += dpp_f<0x4E>(v); v += dpp_f<0x141>(v); return v; }
__device__ __forceinline__ float wave_sum(float v) {
    v = row16_sum(v); v += __shfl_xor(v, 16); v += __shfl_xor(v, 32);
    return v;
}

namespace pg8 {
constexpr int BM = 256, BK = 64, HALF = 128, HTB = HALF * BK * 2, NXCD = 8, WGM = 8;
__device__ __forceinline__ int lds_byte(int r, int c) { const int st = (r >> 4) * 2 + (c >> 5), rr = r & 15, cc = c & 31, ob = rr * 64 + cc * 2; return st * 1024 + (ob ^ (((ob >> 9) & 1) << 5)); }
__device__ __forceinline__ void stage_rc(int b, int& R, int& C) { const int st = b / 1024, sb = b % 1024, swz = sb ^ (((sb >> 9) & 1) << 5); R = (st >> 1) * 16 + swz / 64; C = (st & 1) * 32 + (swz % 64) / 2; }
__device__ __forceinline__ int perm32(int rho) { const int n = rho >> 4, i = rho & 15; return 8 * (i >> 2) + 4 * n + (i & 3); }

struct Unit { int pm, pn, z; };
struct Gemm { const bf16_t* A; const bf16_t* Bt; int M, N, K, lda, ldb; size_t azs, bzs; };
struct Sched {
    int nM, nN, nwg, G, c, nz;
    __device__ void init(int M, int N, int G_, int c_, int nz_) { nM = M / BM; nN = N / BM; nwg = nM * nN; G = G_; c = c_; nz = nz_; }
    __device__ bool next(int i, Unit& u) const {
        const int ti = i / nz; u.z = i - ti * nz;
        const long L = (long)ti * G + c; if (L >= nwg) return false;
        int wgid = (int)L; { const int q = nwg / NXCD, r = nwg % NXCD, xcd = wgid % NXCD, off = wgid / NXCD; wgid = (xcd < r ? xcd * (q + 1) : r * (q + 1) + (xcd - r) * q) + off; }
        const int nig = WGM * nN, gid = wgid / nig, fm = gid * WGM, gsz = (nM - fm) < WGM ? (nM - fm) : WGM;
        u.pm = fm + ((wgid % nig) % gsz); u.pn = (wgid % nig) / gsz; return true;
    }
};

template <class Epi>
__device__ __forceinline__ void gemm_phase(LAS unsigned char* lds, const Gemm g, const Sched& S, const Epi& E) {
    const int tid = tid_(), wid = __builtin_amdgcn_readfirstlane(tid >> 6), lane = tid & 63, wr = wid >> 2, wc = wid & 3, fr = lane & 15, fq = lane >> 4;
    const int K = g.K, nt = K / BK;
    unsigned voffA[2], voffB[2];
#pragma unroll
    for (int i = 0; i < 2; ++i) { int R, C; stage_rc(tid * 16 + i * 8192, R, C); const int Rb = Epi::PERM ? ((R & ~31) + perm32(R & 31)) : R;
        voffA[i] = (unsigned)(R * g.lda + C) * 2u; voffB[i] = (unsigned)(Rb * g.ldb + C) * 2u; }
    const size_t kstep = (size_t)(BK * 2);
    const size_t hsA = (size_t)HALF * g.lda * 2, hsB = (size_t)HALF * g.ldb * 2;
    const unsigned ldsw = (unsigned)wid * 1024u;
    const int aoff = lds_byte(wr * 64 + fr, fq * 8), boff = lds_byte(wc * 32 + fr, fq * 8);
#define PG8_SA(b, h) (((b) * 2 + (h)) * HTB)
#define PG8_SB(b, h) ((4 + (b) * 2 + (h)) * HTB)
#define PG8_STAGE(bufoff, gbase, voff) do { _Pragma("unroll") for (int _i = 0; _i < 2; ++_i) \
        __builtin_amdgcn_global_load_lds((const unsigned*)((const char*)(gbase) + (voff)[_i]), (LAS unsigned*)(lds + (bufoff) + ldsw + _i * 8192), 16, 0, 0); } while (0)
#define PG8_LDA(dst, b, h) do { _Pragma("unroll") for (int m = 0; m < 4; ++m) _Pragma("unroll") for (int k = 0; k < 2; ++k) dst[m][k] = *(const LAS bf16x8*)(lds + PG8_SA(b, h) + aoff + m * 2048 + k * 1024); } while (0)
#define PG8_LDB(dst, b, h) do { _Pragma("unroll") for (int n = 0; n < 2; ++n) _Pragma("unroll") for (int k = 0; k < 2; ++k) dst[n][k] = *(const LAS bf16x8*)(lds + PG8_SB(b, h) + boff + n * 2048 + k * 1024); } while (0)
#define PG8_MMA(ai, bj, At, Bt) do { __builtin_amdgcn_s_setprio(1); _Pragma("unroll") for (int m = 0; m < 4; ++m) _Pragma("unroll") for (int n = 0; n < 2; ++n) _Pragma("unroll") for (int k = 0; k < 2; ++k) \
        acc[ai][bj][m][n] = __builtin_amdgcn_mfma_f32_16x16x32_bf16(Bt[n][k], At[m][k], acc[ai][bj][m][n], 0, 0, 0); __builtin_amdgcn_s_setprio(0); } while (0)
#define PG8_WAIT_V(n) asm volatile("s_waitcnt vmcnt(" #n ")" ::: "memory")
#define PG8_WAIT_L(n) asm volatile("s_waitcnt lgkmcnt(" #n ")" ::: "memory")
#define PG8_BAR __builtin_amdgcn_s_barrier()
#define PG8_SCHED __builtin_amdgcn_sched_barrier(0)
    Unit cur, nxt; int ui = 0;
    if (!S.next(0, cur)) return;
    f32x4 acc[2][2][4][2];
#pragma unroll
    for (int a = 0; a < 2; ++a)
#pragma unroll
        for (int b = 0; b < 2; ++b)
#pragma unroll
            for (int m = 0; m < 4; ++m)
#pragma unroll
                for (int n = 0; n < 2; ++n) acc[a][b][m][n] = (f32x4){0.f, 0.f, 0.f, 0.f};
    bf16x8 At[4][2], B0[2][2], B1[2][2];
    const char* cA = (const char*)g.A + (size_t)cur.pm * 2 * hsA + (size_t)cur.z * g.azs;
    const char* cB = (const char*)g.Bt + (size_t)cur.pn * 2 * hsB + (size_t)cur.z * g.bzs;
    PG8_STAGE(PG8_SB(0, 0), cB, voffB); PG8_STAGE(PG8_SA(0, 0), cA, voffA); PG8_STAGE(PG8_SB(0, 1), cB + hsB, voffB); PG8_STAGE(PG8_SA(0, 1), cA + hsA, voffA);
    if (wr == 1) PG8_BAR;
    PG8_WAIT_V(4); PG8_BAR;
    PG8_STAGE(PG8_SB(1, 0), cB + kstep, voffB); PG8_STAGE(PG8_SA(1, 0), cA + kstep, voffA); PG8_STAGE(PG8_SB(1, 1), cB + hsB + kstep, voffB);
    PG8_WAIT_V(6); PG8_BAR;
    for (;;) {
        const bool has_next = S.next(ui + 1, nxt);
        const char* nA = has_next ? (const char*)g.A + (size_t)nxt.pm * 2 * hsA + (size_t)nxt.z * g.azs : cA;
        const char* nB = has_next ? (const char*)g.Bt + (size_t)nxt.pn * 2 * hsB + (size_t)nxt.z * g.bzs : cB;
        for (int t = 0; t < nt; t += 2) {
            const bool last = (t == nt - 2);
            const char* a1 = cA + (size_t)(t + 1) * kstep;
            const char* a2 = last ? nA : cA + (size_t)(t + 2) * kstep; const char* b2 = last ? nB : cB + (size_t)(t + 2) * kstep;
            const char* a3 = a2 + kstep; const char* b3 = b2 + kstep;
            PG8_LDB(B0, 0, 0); PG8_SCHED; PG8_LDA(At, 0, 0); PG8_STAGE(PG8_SA(1, 1), a1 + hsA, voffA);
            PG8_WAIT_L(8); PG8_BAR; PG8_WAIT_L(0); PG8_MMA(0, 0, At, B0); PG8_BAR; PG8_SCHED;
            PG8_LDB(B1, 0, 1); PG8_STAGE(PG8_SB(0, 0), b2, voffB);
            PG8_BAR; PG8_WAIT_L(0); PG8_MMA(0, 1, At, B1); PG8_BAR;
            PG8_LDA(At, 0, 1); PG8_STAGE(PG8_SA(0, 0), a2, voffA);
            PG8_BAR; PG8_WAIT_L(0); PG8_MMA(1, 0, At, B0); PG8_BAR; PG8_SCHED;
            PG8_STAGE(PG8_SB(0, 1), b2 + hsB, voffB);
            PG8_WAIT_V(6); PG8_BAR; PG8_MMA(1, 1, At, B1); PG8_BAR;
            PG8_LDB(B0, 1, 0); PG8_SCHED; PG8_LDA(At, 1, 0); PG8_STAGE(PG8_SA(0, 1), a2 + hsA, voffA);
            PG8_WAIT_L(8); PG8_BAR; PG8_WAIT_L(0); PG8_MMA(0, 0, At, B0); PG8_BAR; PG8_SCHED;
            PG8_LDB(B1, 1, 1); PG8_STAGE(PG8_SB(1, 0), b3, voffB);
            PG8_BAR; PG8_WAIT_L(0); PG8_MMA(0, 1, At, B1); PG8_BAR;
            PG8_LDA(At, 1, 1); PG8_STAGE(PG8_SA(1, 0), a3, voffA);
            PG8_BAR; PG8_WAIT_L(0); PG8_MMA(1, 0, At, B0); PG8_BAR; PG8_SCHED;
            PG8_STAGE(PG8_SB(1, 1), b3 + hsB, voffB);
            PG8_WAIT_V(6); PG8_BAR; PG8_MMA(1, 1, At, B1); PG8_BAR;
        }
        const bool zero = E(acc, cur, wr, wc, fr, fq);
        if (!has_next) break;
        if (zero) {
#pragma unroll
            for (int a = 0; a < 2; ++a)
#pragma unroll
                for (int b = 0; b < 2; ++b)
#pragma unroll
                    for (int m = 0; m < 4; ++m)
#pragma unroll
                        for (int n = 0; n < 2; ++n) acc[a][b][m][n] = (f32x4){0.f, 0.f, 0.f, 0.f};
        }
        cur = nxt; cA = nA; cB = nB; ++ui;
    }
    PG8_WAIT_V(0);
    if (wr == 0) PG8_BAR;
    PG8_BAR;
#undef PG8_SA
#undef PG8_SB
#undef PG8_STAGE
#undef PG8_LDA
#undef PG8_LDB
#undef PG8_MMA
#undef PG8_WAIT_V
#undef PG8_WAIT_L
#undef PG8_BAR
#undef PG8_SCHED
}

typedef f32x4 Acc[2][2][4][2];
struct EpiBf16 {
    static constexpr bool PERM = true;
    bf16_t* O; int ldc;
    __device__ __forceinline__ bool operator()(Acc& acc, const Unit& u, int wr, int wc, int fr, int fq) const {
        const int row0 = u.pm * BM + wr * 64 + fr, col0 = u.pn * BM + wc * 32 + 8 * fq;
#pragma unroll
        for (int ai = 0; ai < 2; ++ai)
#pragma unroll
            for (int m = 0; m < 4; ++m) { bf16_t* rowp = O + (size_t)(row0 + ai * HALF + m * 16) * ldc + col0;
#pragma unroll
                for (int bj = 0; bj < 2; ++bj) { const f32x4 v0 = acc[ai][bj][m][0], v1 = acc[ai][bj][m][1];
                    u32x4 o; o[0] = pack2(v0[0], v0[1]); o[1] = pack2(v0[2], v0[3]); o[2] = pack2(v1[0], v1[1]); o[3] = pack2(v1[2], v1[3]);
                    *(u32x4*)(rowp + bj * HALF) = o; } }
        return true;
    }
};
struct EpiF32 {
    static constexpr bool PERM = false;
    float* C; int ldc;
    __device__ __forceinline__ bool operator()(Acc& acc, const Unit& u, int wr, int wc, int fr, int fq) const {
        const int row0 = u.pm * BM + wr * 64 + fr, col0 = u.pn * BM + wc * 32 + 4 * fq;
#pragma unroll
        for (int ai = 0; ai < 2; ++ai)
#pragma unroll
            for (int m = 0; m < 4; ++m) { float* rowp = C + (size_t)(row0 + ai * HALF + m * 16) * ldc + col0;
#pragma unroll
                for (int bj = 0; bj < 2; ++bj)
#pragma unroll
                    for (int n = 0; n < 2; ++n) *(f32x4*)(rowp + bj * HALF + n * 16) = acc[ai][bj][m][n]; }
        return true;
    }
};
struct EpiRes {
    static constexpr bool PERM = false;
    const float* xin; float* xout; const float* gate;
    __device__ __forceinline__ bool operator()(Acc& acc, const Unit& u, int wr, int wc, int fr, int fq) const {
        const int row0 = u.pm * BM + wr * 64 + fr, col0 = u.pn * BM + wc * 32 + 4 * fq;
        f32x4 gv[2][2];
#pragma unroll
        for (int bj = 0; bj < 2; ++bj)
#pragma unroll
            for (int n = 0; n < 2; ++n) gv[bj][n] = *(const f32x4*)(gate + col0 + bj * HALF + n * 16);
#pragma unroll
        for (int ai = 0; ai < 2; ++ai)
#pragma unroll
            for (int mp = 0; mp < 2; ++mp) {
                f32x4 xi[2][2][2];
#pragma unroll
                for (int mm = 0; mm < 2; ++mm) { const size_t ro = (size_t)(row0 + ai * HALF + (mp * 2 + mm) * 16) * D + col0;
#pragma unroll
                    for (int bj = 0; bj < 2; ++bj)
#pragma unroll
                        for (int n = 0; n < 2; ++n) xi[mm][bj][n] = *(const f32x4*)(xin + ro + bj * HALF + n * 16); }
                __builtin_amdgcn_sched_barrier(0);
#pragma unroll
                for (int mm = 0; mm < 2; ++mm) { const int m = mp * 2 + mm; const size_t ro = (size_t)(row0 + ai * HALF + m * 16) * D + col0;
#pragma unroll
                    for (int bj = 0; bj < 2; ++bj)
#pragma unroll
                        for (int n = 0; n < 2; ++n) *(f32x4*)(xout + ro + bj * HALF + n * 16) = xi[mm][bj][n] + gv[bj][n] * acc[ai][bj][m][n]; }
                __builtin_amdgcn_sched_barrier(0); }
        return true;
    }
};
struct EpiSwiGLU {
    static constexpr bool PERM = true;
    bf16_t* O;
    __device__ __forceinline__ bool operator()(Acc& acc, const Unit& u, int wr, int wc, int fr, int fq) const {
        const int row0 = u.pm * BM + wr * 64 + fr, col0 = u.pn * HALF + wc * 32 + 8 * fq;
#pragma unroll
        for (int ai = 0; ai < 2; ++ai)
#pragma unroll
            for (int m = 0; m < 4; ++m) { bf16_t* rowp = O + (size_t)(row0 + ai * HALF + m * 16) * FF + col0;
                float r[8];
#pragma unroll
                for (int n = 0; n < 2; ++n)
#pragma unroll
                    for (int i = 0; i < 4; ++i) { const float gt = acc[ai][0][m][n][i], vl = acc[ai][1][m][n][i]; r[n * 4 + i] = gt * __builtin_amdgcn_rcpf(1.0f + __expf(-gt)) * vl; }
                *(u32x4*)rowp = pack8(r); }
        return true;
    }
};
struct EpiGate {
    static constexpr bool PERM = true;
    const bf16_t* P; bf16_t* O;
    __device__ __forceinline__ bool operator()(Acc& acc, const Unit& u, int wr, int wc, int fr, int fq) const {
        const int row0 = u.pm * BM + wr * 64 + fr, col0 = u.pn * BM + wc * 32 + 8 * fq;
        const int z1 = u.z < 3 ? u.z + 1 : u.z;
#pragma unroll
        for (int ai = 0; ai < 2; ++ai) {
            u32x4 LZ[2][4], L1[2][4];
#pragma unroll
            for (int bj = 0; bj < 2; ++bj)
#pragma unroll
                for (int m = 0; m < 4; ++m) { const bf16_t* rp = P + (size_t)(row0 + ai * HALF + m * 16) * NINP + col0 + bj * HALF;
                    LZ[bj][m] = *(const u32x4*)(rp + u.z * D); L1[bj][m] = *(const u32x4*)(rp + z1 * D); }
            __builtin_amdgcn_sched_barrier(0);
#pragma unroll
            for (int bj = 0; bj < 2; ++bj) { const int col = col0 + bj * HALF;
#pragma unroll
                for (int m = 0; m < 4; ++m) { const int row = row0 + ai * HALF + m * 16;
                    float lz[8], l1[8], fac[8]; unpack8(LZ[bj][m], lz); unpack8(L1[bj][m], l1);
                    if (u.z < 3) {
#pragma unroll
                        for (int i = 0; i < 8; ++i) fac[i] = (1.0f + __expf(-l1[i])) * __builtin_amdgcn_rcpf(1.0f + __expf(-lz[i])); }
                    else {
#pragma unroll
                        for (int i = 0; i < 8; ++i) fac[i] = __builtin_amdgcn_rcpf(1.0f + __expf(-lz[i])); }
#pragma unroll
                    for (int n = 0; n < 2; ++n)
#pragma unroll
                        for (int i = 0; i < 4; ++i) acc[ai][bj][m][n][i] *= fac[n * 4 + i];
                    if (u.z == 3) { float r[8];
#pragma unroll
                        for (int n = 0; n < 2; ++n)
#pragma unroll
                            for (int i = 0; i < 4; ++i) r[n * 4 + i] = acc[ai][bj][m][n][i];
                        *(u32x4*)(O + (size_t)row * D + col) = pack8(r); } } }
            __builtin_amdgcn_sched_barrier(0); }
        return u.z == 3;
    }
};
}

#define XB_TMO      128
#define XB_XCNT(j)  (256  + 64 * (j))
#define XB_XSUB(j)  (1280 + 64 * (j))
#define XB_XGEN(j)  (2304 + 64 * (j))
#define XB_TOP      3328
#define XB_TOPGEN   3392
#define XCD_BAR_WORDS 3456
#define XB_SPIN_CAP (1u << 18)

__device__ __forceinline__ unsigned xb_ld(unsigned* p)              { return __hip_atomic_load(p, __ATOMIC_RELAXED, __HIP_MEMORY_SCOPE_AGENT); }
__device__ __forceinline__ unsigned xb_add(unsigned* p, unsigned v) { return __hip_atomic_fetch_add(p, v, __ATOMIC_RELAXED, __HIP_MEMORY_SCOPE_AGENT); }
__device__ __forceinline__ unsigned xb_xcc_id() { return (unsigned)__builtin_amdgcn_s_getreg((3 << 11) | 20) & 0xFu; }
#define XB_SPIN(cond, bar) do { unsigned _sp = 0; while (cond) { __builtin_amdgcn_s_sleep(1); \
    if ((++_sp & 255u) == 0u) { if (xb_ld(&(bar)[XB_TMO])) break; if (_sp > XB_SPIN_CAP) { atomicAdd(&(bar)[XB_TMO], 1u); break; } } } } while (0)

struct XcdBarrier {
    unsigned total;
    unsigned* bar; unsigned x;
    volatile LAS unsigned* st;
};

__device__ __forceinline__ XcdBarrier xcd_barrier_post(unsigned* bar, volatile LAS unsigned* st, unsigned total) {
    XcdBarrier b; b.total = total; b.bar = bar; b.x = xb_xcc_id(); b.st = st;
    if (threadIdx.x == 0) (void)xb_add(&bar[XB_XCNT(b.x)], 1u);
    return b;
}
__device__ __forceinline__ void xcd_barrier_complete(unsigned* bar, unsigned x, unsigned& nloc, unsigned& nx, unsigned G) {
    unsigned sum, cnt, mine, sp = 0u;
    for (;;) {
        sum = 0u; cnt = 0u; mine = 0u;
#pragma unroll
        for (unsigned j = 0; j < 16; ++j) { const unsigned c = xb_ld(&bar[XB_XCNT(j)]); sum += c; cnt += (c > 0u) ? 1u : 0u; mine = (j == x) ? c : mine; }
        if (sum == G) break;
        __builtin_amdgcn_s_sleep(1);
        if ((++sp & 255u) == 0u) { if (xb_ld(&bar[XB_TMO])) break; if (sp > XB_SPIN_CAP) { atomicAdd(&bar[XB_TMO], 1u); break; } }
    }
    nloc = mine > 0u ? mine : 1u; nx = cnt > 0u ? cnt : 1u;
}

__device__ __forceinline__ void xcd_barrier(const XcdBarrier& b) {
    asm volatile("s_waitcnt vmcnt(0)" ::: "memory");
    __syncthreads();
    if (threadIdx.x == 0) {
        unsigned* bar = b.bar;
        __builtin_amdgcn_s_waitcnt(0);
        unsigned nloc = b.st[0], nx = b.st[1];
        if (nloc == 0u) { xcd_barrier_complete(bar, b.x, nloc, nx, b.total); b.st[0] = nloc; b.st[1] = nx; }
        const unsigned old = xb_add(&bar[XB_XSUB(b.x)], 1u);
        const unsigned gen = old / nloc;
        if (old + 1u == (gen + 1u) * nloc) {
            __builtin_amdgcn_fence(__ATOMIC_RELEASE, "agent");
            asm volatile("s_waitcnt vmcnt(0)" ::: "memory");
            const unsigned og = xb_add(&bar[XB_TOP], 1u);
            const unsigned tg = og / nx;
            if (og + 1u == (tg + 1u) * nx) xb_add(&bar[XB_TOPGEN], 1u);
            else XB_SPIN(xb_ld(&bar[XB_TOPGEN]) == tg, bar);
            __builtin_amdgcn_fence(__ATOMIC_ACQUIRE, "agent");
            xb_add(&bar[XB_XGEN(b.x)], 1u);
            asm volatile("s_waitcnt vmcnt(0)" ::: "memory");
        } else {
            XB_SPIN(xb_ld(&bar[XB_XGEN(b.x)]) == gen, bar);
            __builtin_amdgcn_fence(__ATOMIC_ACQUIRE, "agent");
            asm volatile("s_waitcnt vmcnt(0)" ::: "memory");
        }
    }
    __syncthreads();
}


#define WSP(type, off) ((type*)(p.ws + (off)))

__device__ __forceinline__ void conv_tile(float* tile, const float* src, int ldsrc, int k0, int n0, int nvalid, bf16_t* dst, int lddst, int kd0, int drow0, const float* kscale) {
    const int tid = tid_();
    { const int nn = tid & 63, kq = tid >> 6;
#pragma unroll
      for (int i = 0; i < 8; ++i) { const int kk = i * 8 + kq; const int n = n0 + nn; float v = 0.f;
          if (src && n < nvalid) { v = src[(size_t)(k0 + kk) * ldsrc + n]; if (kscale) v *= kscale[k0 + kk]; }
          tile[kk * 65 + nn] = v; } }
    __syncthreads();
    { const int kp = tid & 31, nq = tid >> 5;
#pragma unroll
      for (int i = 0; i < 4; ++i) { const int nn = i * 16 + nq; const float v0 = tile[(2 * kp) * 65 + nn], v1 = tile[(2 * kp + 1) * 65 + nn];
          *(unsigned*)(dst + (size_t)(drow0 + nn) * lddst + kd0 + 2 * kp) = pack2(v0, v1); } }
    __syncthreads();
}

struct ConvT { const float* src; bf16_t* dst; int ldsrc, lddst, nvalid; };
__device__ __forceinline__ ConvT conv_decode(const Params& p, int l, int i) {
    ConvT t; t.nvalid = 1 << 30;
    constexpr int N0 = 216 * 16, N1 = 176 * 16, N2 = 32 * 44, N3 = 32 * 16;
    if (i < N0) { const int nt = i >> 4, kt = i & 15; t.src = p.w_in + (size_t)l * D * NIN + (size_t)kt * 128 * NIN + nt * 64; t.ldsrc = NIN;
        t.dst = WSP(bf16_t, O_WT_IN) + (size_t)nt * 64 * D + kt * 128; t.lddst = D; t.nvalid = NIN - nt * 64; return t; }
    i -= N0;
    if (i < N1) { const int nt = i >> 4, kt = i & 15; const int c0 = nt * 64;
        int drow; if (c0 < FF) drow = 256 * (c0 >> 7) + (c0 & 127); else { const int j = c0 - FF; drow = 256 * (j >> 7) + 128 + (j & 127); }
        t.src = p.ffn_w_in + (size_t)l * D * 2 * FF + (size_t)kt * 128 * 2 * FF + c0; t.ldsrc = 2 * FF; t.dst = WSP(bf16_t, O_WT_FFI) + (size_t)drow * D + kt * 128; t.lddst = D; return t; }
    i -= N1;
    if (i < N2) { const int nt = i / 44, kt = i % 44; t.src = p.ffn_w_out + (size_t)l * FF * D + (size_t)kt * 128 * D + nt * 64; t.ldsrc = D;
        t.dst = WSP(bf16_t, O_WT_FFO) + (size_t)nt * 64 * FF + kt * 128; t.lddst = FF; return t; }
    i -= N2;
    if (i < N3) { const int nt = i >> 4, kt = i & 15; t.src = p.w_out + (size_t)l * D * D + (size_t)kt * 128 * D + nt * 64; t.ldsrc = D;
        t.dst = WSP(bf16_t, O_WT_OUT) + (size_t)nt * 64 * D + kt * 128; t.lddst = D; return t; }
    i -= N3;
    { const int z = i >> 7, r = i & 127, nt = r >> 2, kt = r & 3; t.src = p.w_branch + ((size_t)l * 4 + z) * 512 * D + (size_t)kt * 128 * D + nt * 64; t.ldsrc = D;
      t.dst = WSP(bf16_t, O_WT_BR) + (size_t)z * D * 512 + (size_t)nt * 64 * 512 + kt * 128; t.lddst = 512; return t; }
}
constexpr int CONV_N0 = 216 * 16, CONV_NBIG = 216 * 16 + 176 * 16 + 32 * 44 + 32 * 16 + 4 * 32 * 4;
__device__ __forceinline__ void phase_convert(const Params& p, int l, unsigned char* lds, int i0, int NBIG, bool do_small, int bb, int G) {
    float* tile = (float*)lds;
    const int tid = tid_();
    if (i0 < NBIG) {
        const int n4 = tid & 15, kq = tid >> 4, nn = tid & 63, kp = tid >> 6;
        f32x4 r[4];
        int it = i0 + bb;
        ConvT cur = conv_decode(p, l, it < NBIG ? it : 0);
        if (it < NBIG) {
#pragma unroll
            for (int i = 0; i < 4; ++i) r[i] = (n4 * 4 < cur.nvalid) ? __builtin_nontemporal_load((const f32x4*)(cur.src + (size_t)(i * 32 + kq) * cur.ldsrc + n4 * 4)) : (f32x4){0.f, 0.f, 0.f, 0.f};
        }
        while (it < NBIG) {
#pragma unroll
            for (int i = 0; i < 4; ++i) *(f32x4*)(tile + (i * 32 + kq) * 68 + n4 * 4) = r[i];
            __syncthreads();
            const int itn = it + G; const ConvT nx = conv_decode(p, l, itn < NBIG ? itn : 0);
            if (itn < NBIG) {
#pragma unroll
                for (int i = 0; i < 4; ++i) r[i] = (n4 * 4 < nx.nvalid) ? __builtin_nontemporal_load((const f32x4*)(nx.src + (size_t)(i * 32 + kq) * nx.ldsrc + n4 * 4)) : (f32x4){0.f, 0.f, 0.f, 0.f};
            }
            float v[16];
#pragma unroll
            for (int j = 0; j < 16; ++j) v[j] = tile[(kp * 16 + j) * 68 + nn];
            bf16_t* d = cur.dst + (size_t)nn * cur.lddst + kp * 16;
            *(u32x4*)d = pack8(v); *(u32x4*)(d + 8) = pack8(v + 8);
            __syncthreads();
            cur = nx; it = itn;
        }
    }
    constexpr int N5 = 12 * 6, N6 = 16 * 4, N7 = 24 * 4;
    if (do_small)
    for (int it = bb; it < N5 + N6 + N7; it += G) {
        int i = it;
        if (i < N5) { const int nt = i / 6, kt = i % 6;
            conv_tile(tile, p.mla_w_uq + (size_t)l * 384 * 768, 768, kt * 64, nt * 64, 768, WSP(bf16_t, O_WT_UQ), 384, kt * 64, nt * 64, p.mla_g_cq + l * 384); continue; }
        i -= N5;
        if (i < N6) { const int nt = i >> 2, kt = i & 3;
            conv_tile(tile, p.mla_w_ukv + (size_t)l * 256 * 1024, 1024, kt * 64, nt * 64, 1024, WSP(bf16_t, O_WT_UKV), 256, kt * 64, nt * 64, p.mla_g_ckv + l * 256); continue; }
        i -= N6;
        { const int nt = i >> 2, kt = i & 3;
          const float* src = nullptr; int k0 = 0, n0 = (nt & 7) * 64;
          if (nt < 8) { if (kt == 0) { src = p.rwkv_w_up + (size_t)l * 64 * 512; k0 = 0; } }
          else if (nt < 16) { if (kt == 1) { src = p.rwkv_a_up + (size_t)l * 64 * 512; k0 = 0; } }
          else { if (kt >= 2) { src = p.rwkv_g_up + (size_t)l * 128 * 512; k0 = (kt - 2) * 64; } }
          conv_tile(tile, src, 512, k0, n0, 512, WSP(bf16_t, O_WT_LORA), 256, kt * 64, nt * 64, nullptr); }
    }
}

__device__ __forceinline__ void phase_init(const Params& p, unsigned char* lds) {
    const int tid = tid_(), G = gridDim.x, w = tid >> 6, lane = tid & 63;
    float* cact = (float*)lds; float* red = cact + D;
    for (int it = blockIdx.x; it < 192; it += G) {
        const int l = it / 96, cgp = it % 96;
        for (int i = tid; i < D; i += NTHR) { const float cv = p.c[i]; cact[i] = cv / (1.0f + __expf(-cv)); }
        __syncthreads();
        const int sub = lane >> 5, cl = (lane & 31) * 4;
        f32x4 a = {0.f, 0.f, 0.f, 0.f};
        const float* wb = p.ada_w + (size_t)l * D * 6 * D + cgp * 128 + cl;
        for (int kk = 0; kk < 128; ++kk) { const int k = w * 256 + kk * 2 + sub; const f32x4 wv = __builtin_nontemporal_load((const f32x4*)(wb + (size_t)k * 6 * D)); a += cact[k] * wv; }
        *(f32x4*)(red + (w * 2 + sub) * 128 + cl) = a;
        __syncthreads();
        if (tid < 128) { float s = p.ada_b[l * 6 * D + cgp * 128 + tid];
#pragma unroll
            for (int j = 0; j < 16; ++j) s += red[j * 128 + tid];
            WSP(float, O_MOD)[l * 6 * D + cgp * 128 + tid] = s; }
        __syncthreads();
    }
    for (int idx = blockIdx.x * NTHR + tid; idx < T * 96; idx += G * NTHR) {
        const int t = idx / 96, j = idx % 96; const int dim = j < 32 ? 64 : 128, i = j < 32 ? j : j - 32;
        const float inv = INVF[j < 32 ? 2 * i : i];
        const float ang = (float)p.pos[t] * inv;
        const float kq = rintf(ang * 0.15915494309189535f);
        float rr = fmaf(-kq, 6.28125f, ang); rr = fmaf(-kq, 0.0019350051879882812f, rr); rr = fmaf(-kq, 3.019916e-07f, rr);
        const float rev = rr * 0.15915494309189535f; const float cs = __builtin_amdgcn_cosf(rev), sn = __builtin_amdgcn_sinf(rev);
        if (j < 32) { WSP(float, O_COSM)[t * 32 + i] = cs; WSP(float, O_SINM)[t * 32 + i] = sn; }
        else { WSP(float, O_COSR)[t * 64 + i] = cs; WSP(float, O_SINR)[t * 64 + i] = sn; }
    }
}

__device__ __forceinline__ void phase_norm(const Params& p, const float* xsrc, const float* gw, const float* scale, const float* shift) {
    const int tid = tid_(), w = tid >> 6, lane = tid & 63;
    bf16_t* hb = WSP(bf16_t, O_HBUF);
    f32x4 cf[8], shv[8];
#pragma unroll
    for (int i = 0; i < 8; ++i) { const int c = (i * 64 + lane) * 4; const f32x4 gg = *(const f32x4*)(gw + c), sc = *(const f32x4*)(scale + c); cf[i] = gg * (1.0f + sc); shv[i] = *(const f32x4*)(shift + c); }
    __builtin_amdgcn_sched_barrier(0);
    for (int row = blockIdx.x * 8 + w; row < T; row += gridDim.x * 8) {
        const float* xr = xsrc + (size_t)row * D; f32x4 v[8]; float ss = 0.f;
#pragma unroll
        for (int i = 0; i < 8; ++i) v[i] = *(const f32x4*)(xr + (i * 64 + lane) * 4);
        __builtin_amdgcn_sched_barrier(0);
#pragma unroll
        for (int i = 0; i < 8; ++i) ss += v[i][0] * v[i][0] + v[i][1] * v[i][1] + v[i][2] * v[i][2] + v[i][3] * v[i][3];
        ss = wave_sum(ss); const float rs = rsqrtf(ss * (1.0f / D) + 1e-6f);
#pragma unroll
        for (int i = 0; i < 8; ++i) { const int c = (i * 64 + lane) * 4;
            float o[4];
#pragma unroll
            for (int j = 0; j < 4; ++j) o[j] = v[i][j] * rs * cf[i][j] + shv[i][j];
            u32x2 st; st[0] = pack2(o[0], o[1]); st[1] = pack2(o[2], o[3]); *(u32x2*)(hb + (size_t)row * D + c) = st; }
    }
}

__device__ __forceinline__ void phase_prep1(const Params& p, int l, unsigned char* lds, int bb, int G) {
    const int tid = tid_(), w = tid >> 6, lane = tid & 63;
    const bf16_t* P = WSP(bf16_t, O_P);
    {
        float* xa = (float*)lds; float* wrs = xa + 64 * 65; float* wis = wrs + 4096; float* As = wis + 4096; float* Us = As + 64 * 65;
        for (int it = bb; it < 1024; it += G) {
            const int tt = it >> 3, n = it & 7; const int c = tid & 63, tg = tid >> 6, cc = n * 64 + c;
            { const float cw0 = p.conv_w[(l * 4 + 0) * 512 + cc], cw1 = p.conv_w[(l * 4 + 1) * 512 + cc], cw2 = p.conv_w[(l * 4 + 2) * 512 + cc], cw3 = p.conv_w[(l * 4 + 3) * 512 + cc], cb = p.conv_b[l * 512 + cc];
              { float xv[11]; const int tb = tt * 64 + tg * 8 - 3;
#pragma unroll
                for (int j = 0; j < 11; ++j) { const int tj = tb + j; const float x = bf2f(P[(size_t)(tj < 0 ? 0 : tj) * NINP + PAX + cc]); xv[j] = tj < 0 ? 0.f : x; }
                __builtin_amdgcn_sched_barrier(0);
#pragma unroll
                for (int i = 0; i < 8; ++i) xa[(tg * 8 + i) * 65 + c] = cb + cw0 * xv[i] + cw1 * xv[i + 1] + cw2 * xv[i + 2] + cw3 * xv[i + 3]; }
#pragma unroll
              for (int i = 0; i < 8; ++i) { const int e = i * 512 + tid; wrs[e] = p.lru_wr[((size_t)l * 8 + n) * 4096 + e]; wis[e] = p.lru_wi[((size_t)l * 8 + n) * 4096 + e]; } }
            __syncthreads();
            { float ra[8], ia[8];
#pragma unroll
              for (int k = 0; k < 8; ++k) { ra[k] = 0.f; ia[k] = 0.f; }
              for (int i = 0; i < 64; ++i) { const float wv = wrs[i * 64 + c], wi = wis[i * 64 + c];
#pragma unroll
                  for (int k = 0; k < 8; ++k) { const float xv = xa[(tg * 8 + k) * 65 + i]; ra[k] += xv * wv; ia[k] += xv * wi; } }
              const float br = p.lru_br[l * 512 + cc], bi = p.lru_bi[l * 512 + cc], lam = p.lru_lam[l * 512 + cc];
              const float sp = log1pf(__expf(-lam));
#pragma unroll
              for (int k = 0; k < 8; ++k) { const float r = sigmoidf_(ra[k] + br), ig = sigmoidf_(ia[k] + bi);
                  const float log_a = -8.0f * sp * r; const float a = __expf(log_a);
                  const float u = sqrtf(-expm1f(2.0f * log_a)) * (ig * xa[(tg * 8 + k) * 65 + c]);
                  As[(tg * 8 + k) * 65 + c] = a; Us[(tg * 8 + k) * 65 + c] = u; } }
            __syncthreads();
            {
              float hl8[8], pl8[8]; float h = 0.f, pr = 1.f;
#pragma unroll
              for (int i = 0; i < 8; ++i) { const float a = As[(tg * 8 + i) * 65 + c]; h = a * h + Us[(tg * 8 + i) * 65 + c]; pr *= a; hl8[i] = h; pl8[i] = pr; }
              float* segA = wrs; float* segH = wrs + 512;
              segA[tg * 64 + c] = pr; segH[tg * 64 + c] = h;
              __syncthreads();
              float carry = 0.f, pin = 1.f;
              for (int s2 = 0; s2 < tg; ++s2) { const float a = segA[s2 * 64 + c]; carry = a * carry + segH[s2 * 64 + c]; pin *= a; }
              float* hlg = WSP(float, O_HLOC) + (size_t)(tt * 64 + tg * 8) * 512 + cc; float* pcg = WSP(float, O_PC) + (size_t)(tt * 64 + tg * 8) * 512 + cc;
#pragma unroll
              for (int i = 0; i < 8; ++i) { hlg[(size_t)i * 512] = hl8[i] + pl8[i] * carry; pcg[(size_t)i * 512] = pl8[i] * pin; }
              if (tg == 7) { WSP(float, O_TILEA)[tt * 512 + cc] = pl8[7] * pin; WSP(float, O_TILEH)[tt * 512 + cc] = hl8[7] + pl8[7] * carry; } }
            __syncthreads();
        }
    }
    for (int t = bb * 8 + w; t < T; t += G * 8) {
        const bf16_t* pr = P + (size_t)t * NINP;
        unsigned q[3]; float ss = 0.f;
#pragma unroll
        for (int i = 0; i < 3; ++i) { q[i] = *(const unsigned*)(pr + PCQ + (i * 64 + lane) * 2); const float a = bflo(q[i]), b = bfhi(q[i]); ss += a * a + b * b; }
        ss = wave_sum(ss); float rs = rsqrtf(ss * (1.0f / 384.0f) + 1e-6f);
#pragma unroll
        for (int i = 0; i < 3; ++i) *(unsigned*)(WSP(bf16_t, O_CQN) + (size_t)t * 384 + (i * 64 + lane) * 2) = pack2(bflo(q[i]) * rs, bfhi(q[i]) * rs);
        unsigned kv[2]; ss = 0.f;
#pragma unroll
        for (int i = 0; i < 2; ++i) { kv[i] = *(const unsigned*)(pr + PCKV + (i * 64 + lane) * 2); const float a = bflo(kv[i]), b = bfhi(kv[i]); ss += a * a + b * b; }
        ss = wave_sum(ss); rs = rsqrtf(ss * (1.0f / 256.0f) + 1e-6f);
#pragma unroll
        for (int i = 0; i < 2; ++i) *(unsigned*)(WSP(bf16_t, O_CKVN) + (size_t)t * 256 + (i * 64 + lane) * 2) = pack2(bflo(kv[i]) * rs, bfhi(kv[i]) * rs);
    }
    {
        bf16_t* tl = (bf16_t*)lds;
        const float* cosr = WSP(float, O_COSR); const float* sinr = WSP(float, O_SINR);
        for (int it = bb; it < 512; it += G) {
            const int tt = it >> 2, h = it & 3; const int tloc = tid >> 3, seg = tid & 7; const int t = tt * 64 + tloc;
            const float lg = ret_lg(h);
            const float kdec = __expf(lg * (float)(127 - (t & 127)));
            float cs[8], sn[8];
            { const f32x4 c0 = *(const f32x4*)(cosr + t * 64 + seg * 8), c1 = *(const f32x4*)(cosr + t * 64 + seg * 8 + 4), s0 = *(const f32x4*)(sinr + t * 64 + seg * 8), s1 = *(const f32x4*)(sinr + t * 64 + seg * 8 + 4);
#pragma unroll
              for (int i = 0; i < 4; ++i) { cs[i] = c0[i]; cs[4 + i] = c1[i]; sn[i] = s0[i]; sn[4 + i] = s1[i]; } }
            const bf16_t* pr = P + (size_t)t * NINP + PRET + h * 128 + seg * 8;
            float x1[8], x2[8], o1[8], o2[8];
            unpack8(*(const u32x4*)(pr), x1); unpack8(*(const u32x4*)(pr + 64), x2);
#pragma unroll
            for (int i = 0; i < 8; ++i) { o1[i] = x1[i] * cs[i] - x2[i] * sn[i]; o2[i] = x1[i] * sn[i] + x2[i] * cs[i]; }
            *(u32x4*)(WSP(bf16_t, O_RQ) + (size_t)t * 512 + h * 128 + seg * 8) = pack8(o1);
            *(u32x4*)(WSP(bf16_t, O_RQ) + (size_t)t * 512 + h * 128 + 64 + seg * 8) = pack8(o2);
            unpack8(*(const u32x4*)(pr + 512), x1); unpack8(*(const u32x4*)(pr + 512 + 64), x2);
#pragma unroll
            for (int i = 0; i < 8; ++i) { o1[i] = (x1[i] * cs[i] - x2[i] * sn[i]) * 0.08838834764831845f; o2[i] = (x1[i] * sn[i] + x2[i] * cs[i]) * 0.08838834764831845f; }
            *(u32x4*)(WSP(bf16_t, O_RK) + (size_t)t * 512 + h * 128 + seg * 8) = pack8(o1);
            *(u32x4*)(WSP(bf16_t, O_RK) + (size_t)t * 512 + h * 128 + 64 + seg * 8) = pack8(o2);
#pragma unroll
            for (int i = 0; i < 8; ++i) { tl[(seg * 8 + i) * 72 + tloc] = f2bf(o1[i] * kdec); tl[(64 + seg * 8 + i) * 72 + tloc] = f2bf(o2[i] * kdec); }
            __syncthreads();
            { const int d = tid >> 2, q4 = tid & 3; bf16_t* dst = WSP(bf16_t, O_RKDT) + (size_t)(h * 128 + d) * T + tt * 64 + q4 * 16;
              *(u32x4*)dst = *(const u32x4*)(tl + d * 72 + q4 * 16); *(u32x4*)(dst + 8) = *(const u32x4*)(tl + d * 72 + q4 * 16 + 8); }
            __syncthreads();
            { const u32x4 v1 = *(const u32x4*)(pr + 1024), v2 = *(const u32x4*)(pr + 1024 + 64);
              const bf16_t* a = (const bf16_t*)&v1; const bf16_t* b = (const bf16_t*)&v2;
#pragma unroll
              for (int i = 0; i < 8; ++i) { tl[(seg * 8 + i) * 72 + tloc] = a[i]; tl[(64 + seg * 8 + i) * 72 + tloc] = b[i]; } }
            __syncthreads();
            { const int d = tid >> 2, q4 = tid & 3; bf16_t* dst = WSP(bf16_t, O_RVT) + (size_t)(h * 128 + d) * T + tt * 64 + q4 * 16;
              *(u32x4*)dst = *(const u32x4*)(tl + d * 72 + q4 * 16); *(u32x4*)(dst + 8) = *(const u32x4*)(tl + d * 72 + q4 * 16 + 8); }
            __syncthreads();
        }
    }
}

__device__ __forceinline__ void phase_r1(const Params& p, int l) {
    const int tid = tid_(), G = gridDim.x;
    const bf16_t* P = WSP(bf16_t, O_P);
#pragma unroll 4
    for (int tp = blockIdx.x; tp < T / 2; tp += G) {
        const int j = tid & 255, t = tp * 2 + (tid >> 8); const int pc = PRW + 1536 + j;
        const bf16_t curb = P[(size_t)t * NINP + pc], prevb = P[(size_t)(t > 0 ? t - 1 : t) * NINP + pc];
        const float cur = bf2f(curb); const float prev = t > 0 ? bf2f(prevb) : 0.f;
        const float xs = cur + (prev - cur) * p.rwkv_mu[l * 1792 + 1536 + j];
        float o; if (j < 64) o = tanhf(xs); else if (j < 128) o = xs; else o = sigmoidf_(xs);
        WSP(bf16_t, O_LORAA)[(size_t)t * 256 + j] = f2bf(o);
    }
}


__device__ __forceinline__ void phase_mid(const Params& p, int l, unsigned char* lds, int b, int G) {
    LAS unsigned char* L = (LAS unsigned char*)lds;
    { pg8::Gemm g{WSP(bf16_t, O_CQN), WSP(bf16_t, O_WT_UQ), T, 768, 384, 384, 384, 0, 0}; pg8::Sched S; S.init(T, 768, G, b, 1);
      pg8::EpiBf16 E{WSP(bf16_t, O_QRAW), 768}; pg8::gemm_phase(L, g, S, E); }
    { pg8::Gemm g{WSP(bf16_t, O_CKVN), WSP(bf16_t, O_WT_UKV), T, 1024, 256, 256, 256, 0, 0}; pg8::Sched S; S.init(T, 1024, G, (b + G - (96 % G)) % G, 1);
      pg8::EpiBf16 E{WSP(bf16_t, O_KVRAW), 1024}; pg8::gemm_phase(L, g, S, E); }
    __syncthreads();
    if (b == G - 1) { const int c = tid_(); float carry = 0.f;
        for (int t0 = 0; t0 < 128; t0 += 32) { float av[32], hv[32];
#pragma unroll
            for (int i = 0; i < 32; ++i) { av[i] = WSP(float, O_TILEA)[(t0 + i) * 512 + c]; hv[i] = WSP(float, O_TILEH)[(t0 + i) * 512 + c]; }
            __builtin_amdgcn_sched_barrier(0);
#pragma unroll
            for (int i = 0; i < 32; ++i) { WSP(float, O_CARRY)[(t0 + i) * 512 + c] = carry; carry = av[i] * carry + hv[i]; } } }
    { const int tid = tid_(), w = tid >> 6, lane = tid & 63, fr = lane & 15, g4 = lane >> 4;
      const bf16_t* VT = WSP(bf16_t, O_RVT); const bf16_t* KD = WSP(bf16_t, O_RKDT); float* KV = WSP(float, O_RKV);
      for (int it = b; it < 256; it += G) { const int h = it >> 6, j = it & 63;
          f32x4 acc[8];
#pragma unroll
          for (int nb = 0; nb < 8; ++nb) acc[nb] = (f32x4){0.f, 0.f, 0.f, 0.f};
#pragma unroll
          for (int kp = 0; kp < 2; ++kp) {
              bf16x8 af[2], bfr[2][8];
#pragma unroll
              for (int k2 = 0; k2 < 2; ++k2) { const int t0 = j * 128 + (kp * 2 + k2) * 32 + g4 * 8;
                  af[k2] = *(const bf16x8*)(VT + (size_t)(h * 128 + w * 16 + fr) * T + t0);
#pragma unroll
                  for (int nb = 0; nb < 8; ++nb) bfr[k2][nb] = *(const bf16x8*)(KD + (size_t)(h * 128 + nb * 16 + fr) * T + t0); }
              __builtin_amdgcn_sched_barrier(0);
#pragma unroll
              for (int k2 = 0; k2 < 2; ++k2)
#pragma unroll
                  for (int nb = 0; nb < 8; ++nb) acc[nb] = __builtin_amdgcn_mfma_f32_16x16x32_bf16(af[k2], bfr[k2][nb], acc[nb], 0, 0, 0);
              __builtin_amdgcn_sched_barrier(0); }
          float* o = KV + ((size_t)(h * 64 + j) * 128) * 128;
#pragma unroll
          for (int nb = 0; nb < 8; ++nb)
#pragma unroll
              for (int jj = 0; jj < 4; ++jj) o[(w * 16 + g4 * 4 + jj) * 128 + nb * 16 + fr] = acc[nb][jj]; } }
}

__device__ __forceinline__ void phase_r3(const Params& p, int l) {
    const int tid = tid_(), w = tid >> 6, lane = tid & 63, G = gridDim.x;
    const bf16_t* P = WSP(bf16_t, O_P);
    { const int c = tid; const float mu_r = p.rwkv_mu[l * 1792 + c], mu_k = p.rwkv_mu[l * 1792 + 512 + c], mu_v = p.rwkv_mu[l * 1792 + 1024 + c];
      const float w0 = p.rwkv_w0[l * 512 + c], a0 = p.rwkv_a0[l * 512 + c], kk_ = p.rwkv_k_k[l * 512 + c], ka = p.rwkv_k_a[l * 512 + c], rk = p.rwkv_r_k[l * 512 + c];
      float* scan = WSP(float, O_SCAN); const bf16_t* lo = WSP(bf16_t, O_LORAO);
#pragma unroll 4
      for (int t = blockIdx.x; t < T; t += G) {
          const bf16_t* pc = P + (size_t)t * NINP + PRW + c; const bf16_t* pp = t > 0 ? pc - NINP : pc; const float pf = t > 0 ? 1.0f : 0.0f;
          const bf16_t r0b = pc[0], k0b = pc[512], v0b = pc[1024], r1b = pp[0], k1b = pp[512], v1b = pp[1024], lwb = lo[(size_t)t * 1536 + c], lab = lo[(size_t)t * 1536 + 512 + c];
          const float r0 = bf2f(r0b), k0 = bf2f(k0b), v0 = bf2f(v0b);
          const float r1 = bf2f(r1b) * pf, k1 = bf2f(k1b) * pf, v1 = bf2f(v1b) * pf;
          const float r = r0 + (r1 - r0) * mu_r, k = k0 + (k1 - k0) * mu_k, v = v0 + (v1 - v0) * mu_v;
          const float z = w0 + bf2f(lwb);
          const float wlog = -log1pf(__expf(-z)) - 0.5f; const float dec = __expf(-__expf(wlog));
          const float a = sigmoidf_(a0 + bf2f(lab));
          const float kkr = k * kk_; const float nrm = sqrtf(wave_sum(kkr * kkr)); const float kkn = kkr / fmaxf(nrm, 1e-12f);
          const float kp = k * (1.0f + (a - 1.0f) * ka); const float akk = kkn * a;
          const float c1 = wave_sum(akk * r), c2 = wave_sum(kp * r), bon = wave_sum(r * kp * rk);
          float* sb = scan + ((size_t)(t * 8 + w) * 5) * 64 + lane;
          sb[0] = dec; sb[64] = kp; { f32x2 nr = {-kkn, dec * r}; *(f32x2*)(sb + 128 + lane) = nr; } sb[256] = akk;
          WSP(float, O_RWV)[(size_t)t * 512 + c] = v;
          if (lane == 0) { f32x4 s = {c1 * 0.0625f, c2 * 0.0625f, bon, 0.f}; *(f32x4*)(WSP(float, O_RWS) + (size_t)(t * 8 + w) * 4) = s; }
      } }
}

__device__ __forceinline__ void phase_prep2(const Params& p, int l, unsigned char* lds, int bb, int G) {
    const int tid = tid_(), w = tid >> 6, lane = tid & 63;
    const bf16_t* P = WSP(bf16_t, O_P);
    { const float* cosm = WSP(float, O_COSM); const float* sinm = WSP(float, O_SINM);
      const float gq0 = p.mla_g_qn[l * 192 + lane], gq1 = p.mla_g_qn[l * 192 + 64 + lane], gq2 = p.mla_g_qn[l * 192 + 128 + lane];
      const float gk0 = p.mla_g_kn[l * 192 + lane], gk1 = p.mla_g_kn[l * 192 + 64 + lane], gk2 = p.mla_g_kn[l * 192 + 128 + lane];
      const float qsc = 0.07216878364870323f * 1.4426950408889634f;
#pragma unroll 2
      for (int tp = bb; tp < T / 2; tp += G) { const int t = tp * 2 + (w >> 2), h = w & 3;
          const float cs = cosm[t * 32 + (lane & 31)], sn = sinm[t * 32 + (lane & 31)];
          { const bf16_t* q = WSP(bf16_t, O_QRAW) + (size_t)t * 768 + h * 192;
            float a0 = bf2f(q[lane]), a1 = bf2f(q[64 + lane]), a2 = bf2f(q[128 + lane]);
            const float rs = rsqrtf(wave_sum(a0 * a0 + a1 * a1 + a2 * a2) * (1.0f / 192.0f) + 1e-6f);
            a0 *= rs * gq0; a1 *= rs * gq1; a2 *= rs * gq2;
            const float pa = __shfl_xor(a2, 32); const float ro = lane < 32 ? (a2 * cs - pa * sn) : (pa * sn + a2 * cs);
            bf16_t* qo = WSP(bf16_t, O_MQ) + ((size_t)h * T + t) * 192;
            qo[lane] = f2bf(a0 * qsc); qo[64 + lane] = f2bf(a1 * qsc); qo[128 + lane] = f2bf(ro * qsc); }
          { const bf16_t* kv = WSP(bf16_t, O_KVRAW) + (size_t)t * 1024 + h * 256;
            float a0 = bf2f(kv[lane]), a1 = bf2f(kv[64 + lane]), a2 = bf2f(P[(size_t)t * NINP + PKR + lane]);
            const float rs = rsqrtf(wave_sum(a0 * a0 + a1 * a1 + a2 * a2) * (1.0f / 192.0f) + 1e-6f);
            a0 *= rs * gk0; a1 *= rs * gk1; a2 *= rs * gk2;
            const float pa = __shfl_xor(a2, 32); const float ro = lane < 32 ? (a2 * cs - pa * sn) : (pa * sn + a2 * cs);
            bf16_t* ko = WSP(bf16_t, O_MK) + ((size_t)h * T + t) * 192;
            ko[lane] = f2bf(a0); ko[64 + lane] = f2bf(a1); ko[128 + lane] = f2bf(ro); }
      } }
    { bf16_t* tl = (bf16_t*)lds;
      for (int it = bb; it < 512; it += G) { const int tt = it >> 2, h = it & 3; const int tloc = tid >> 3, seg = tid & 7; const int t = tt * 64 + tloc;
          const bf16_t* src = WSP(bf16_t, O_KVRAW) + (size_t)t * 1024 + h * 256 + 128 + seg * 8;
          const u32x4 v1 = *(const u32x4*)src, v2 = *(const u32x4*)(src + 64);
          const bf16_t* a = (const bf16_t*)&v1; const bf16_t* bq = (const bf16_t*)&v2;
#pragma unroll
          for (int i = 0; i < 8; ++i) { tl[(seg * 8 + i) * 72 + tloc] = a[i]; tl[(64 + seg * 8 + i) * 72 + tloc] = bq[i]; }
          __syncthreads();
          { const int d = tid >> 2, q4 = tid & 3; bf16_t* dst = WSP(bf16_t, O_MVT) + (size_t)(h * 128 + d) * T + tt * 64 + q4 * 16;
            *(u32x4*)dst = *(const u32x4*)(tl + d * 72 + q4 * 16); *(u32x4*)(dst + 8) = *(const u32x4*)(tl + d * 72 + q4 * 16 + 8); }
          __syncthreads(); } }
    for (int e = bb * NTHR + tid; e < 4 * 16384; e += G * NTHR) { const int h = e >> 14, vd = e & 16383;
        const float cd = __expf(ret_lg(h) * 128.0f);
        const float* kv = WSP(float, O_RKV) + (size_t)h * 64 * 16384 + vd; bf16_t* sb = WSP(bf16_t, O_RSB) + (size_t)h * 64 * 16384 + vd; float s = 0.f;
        for (int i0 = 0; i0 < 64; i0 += 32) { float kvv[32];
#pragma unroll
            for (int i = 0; i < 32; ++i) kvv[i] = kv[(size_t)(i0 + i) * 16384];
            __builtin_amdgcn_sched_barrier(0);
#pragma unroll
            for (int i = 0; i < 32; ++i) { sb[(size_t)(i0 + i) * 16384] = f2bf(s); s = cd * s + kvv[i]; } } }
    for (int e = bb * NTHR + tid; e < T * 64; e += G * NTHR) { const int t = e >> 6, c = (e & 63) * 8;
        const float* cp = WSP(float, O_CARRY) + (t >> 6) * 512 + c; const float* hp = WSP(float, O_HLOC) + (size_t)t * 512 + c; const float* pp = WSP(float, O_PC) + (size_t)t * 512 + c;
        const f32x4 c0 = *(const f32x4*)cp, c1 = *(const f32x4*)(cp + 4), h0 = *(const f32x4*)hp, h1 = *(const f32x4*)(hp + 4), p0 = *(const f32x4*)pp, p1 = *(const f32x4*)(pp + 4);
        float g[8], r[8]; unpack8(*(const u32x4*)(P + (size_t)t * NINP + PAG + c), g);
#pragma unroll
        for (int i = 0; i < 8; ++i) { const float hv = i < 4 ? h0[i] + p0[i] * c0[i] : h1[i - 4] + p1[i - 4] * c1[i - 4]; const float gv = g[i];
            r[i] = hv * (gv * __builtin_amdgcn_rcpf(1.0f + __expf(-1.5957691216057308f * (gv + 0.044715f * gv * gv * gv)))); }
        *(u32x4*)(WSP(bf16_t, O_YS) + (size_t)t * D + c) = pack8(r); }
}

__device__ __forceinline__ void rwkv_scan(const Params& p, unsigned char* lds, int b) {
    const int tid = tid_(), w = tid >> 6, lane = tid & 63;
    const int h = b >> 2, rbase = (b & 3) * 16;
    constexpr int CH = 16, NC = T / CH, OV = CH * 1280, BUF = OV + CH * 16 * 8, PB0 = 2 * BUF, PBS = CH * 16 * 64;
    const unsigned char* gscan = (const unsigned char*)WSP(float, O_SCAN);
    const float* gv = WSP(float, O_RWV); const float* gs = WSP(float, O_RWS);
    if (w >= 4) {
        const int lt = tid - 256, step_l = lt >> 4, row_l = lt & 15;
        u32x4 R[2][5]; float Rv[2]; f32x4 Rs[2]; float vc2[2] = {0.f, 0.f};
        int pstep[5], poff[5];
#pragma unroll
        for (int i = 0; i < 5; ++i) { const int piece = lt + i * 256; pstep[i] = piece / 80; poff[i] = piece % 80; }
        float* ob = WSP(float, O_ORAW) + h * 64 + rbase + row_l;
#define SC_ISSUE(c, q) do { _Pragma("unroll") for (int i = 0; i < 5; ++i) R[q][i] = *(const u32x4*)(gscan + ((size_t)(((c) * CH + pstep[i]) * 8 + h)) * 1280 + poff[i] * 16); \
            Rv[q] = gv[(size_t)((c) * CH + step_l) * 512 + h * 64 + rbase + row_l]; Rs[q] = *(const f32x4*)(gs + (size_t)(((c) * CH + step_l) * 8 + h) * 4); } while (0)
#define SC_STORE(buf, q) do { unsigned char* bb = lds + (buf) * BUF; _Pragma("unroll") for (int i = 0; i < 5; ++i) *(u32x4*)(bb + pstep[i] * 1280 + poff[i] * 16) = R[q][i]; \
            { f32x2 vc = {Rv[q], Rs[q][0]}; *(f32x2*)(bb + OV + lt * 8) = vc; } vc2[q] = Rv[q] * Rs[q][1] * 16.0f; } while (0)
#define SC_REDUCE(cprev, q) do { const unsigned char* pb = lds + PB0 + ((cprev) & 1) * PBS + lt * 64; \
            const f32x4 a0 = *(const f32x4*)pb, a1 = *(const f32x4*)(pb + 16), a2 = *(const f32x4*)(pb + 32), a3 = *(const f32x4*)(pb + 48); \
            const f32x4 sm = (a0 + a1) + (a2 + a3); ob[(size_t)((cprev) * CH + step_l) * 512] = ((sm[0] + sm[1]) + (sm[2] + sm[3])) + vc2[q]; } while (0)
        SC_ISSUE(0, 0); SC_STORE(0, 0); SC_ISSUE(1, 1); SC_ISSUE(2, 0);
        __syncthreads();
        for (int c = 0; c < NC; c += 2) {
            if (c > 0) SC_REDUCE(c - 1, 1);
            SC_STORE(1, 1);
            if (c + 3 < NC) SC_ISSUE(c + 3, 1);
            __syncthreads();
            SC_REDUCE(c, 0);
            if (c + 2 < NC) SC_STORE(0, 0);
            if (c + 4 < NC) SC_ISSUE(c + 4, 0);
            __syncthreads();
        }
        SC_REDUCE(NC - 1, 1);
#undef SC_REDUCE
#undef SC_ISSUE
#undef SC_STORE
    } else {
        const int s = lane & 15, rl = w * 4 + (lane >> 4);
        f32x2 S01 = {0.f, 0.f}, S23 = {0.f, 0.f};
        __syncthreads();
        for (int c = 0; c < NC; ++c) {
            const unsigned char* bb = lds + (c & 1) * BUF;
            float* pb = (float*)(lds + PB0 + (c & 1) * PBS) + rl * 16 + s;
            f32x4 qw[2], qk[2], qx[2], qy[2], qa[2]; f32x2 qv[2];
#define SC_LD(j, st) do { const unsigned char* sp = bb + (st) * 1280 + s * 16; qw[j] = *(const f32x4*)(sp); qk[j] = *(const f32x4*)(sp + 256); \
                qx[j] = *(const f32x4*)(bb + (st) * 1280 + 512 + s * 32); qy[j] = *(const f32x4*)(bb + (st) * 1280 + 528 + s * 32); \
                qa[j] = *(const f32x4*)(sp + 1024); qv[j] = *(const f32x2*)(bb + OV + ((st) * 16 + rl) * 8); } while (0)
            SC_LD(0, 0);
#pragma unroll
            for (int st = 0; st < CH; ++st) {
                if (st + 1 < CH) SC_LD((st + 1) & 1, st + 1);
                const int j = st & 1;
                const float vv = qv[j][0];
                const f32x2 w01 = {qw[j][0], qw[j][1]}, w23 = {qw[j][2], qw[j][3]}, k01 = {qk[j][0], qk[j][1]}, k23 = {qk[j][2], qk[j][3]};
                const f32x2 a01 = {qa[j][0], qa[j][1]}, a23 = {qa[j][2], qa[j][3]};
                const f32x2 t01 = S01 * w01 + k01 * vv, t23 = S23 * w23 + k23 * vv;
                f32x2 de = (f32x2){S01[0], S01[0]} * (f32x2){qx[j][0], qx[j][1]};
                de += (f32x2){S01[1], S01[1]} * (f32x2){qx[j][2], qx[j][3]};
                de += (f32x2){S23[0], S23[0]} * (f32x2){qy[j][0], qy[j][1]};
                de += (f32x2){S23[1], S23[1]} * (f32x2){qy[j][2], qy[j][3]};
                const float sa = row16_sum(de[0]);
                pb[st * 256] = de[1] + sa * qv[j][1];
                S01 = a01 * sa + t01; S23 = a23 * sa + t23;
            }
#undef SC_LD
            __syncthreads();
        }
    }
}

__device__ __forceinline__ void attn_unit(const Params& p, unsigned char* lds, int h, int qb) {
    const int tid = tid_(), w = tid >> 6, lane = tid & 63, fr = lane & 15, g4 = lane >> 4, rg = w & 3, kh = w >> 2;
    const bf16_t* Q = WSP(bf16_t, O_MQ) + (size_t)h * T * 192; const bf16_t* K = WSP(bf16_t, O_MK) + (size_t)h * T * 192; const bf16_t* VT = WSP(bf16_t, O_MVT) + (size_t)h * 128 * T;
    constexpr int KSB = 64 * 400, VSB = 128 * 144, BUFB = KSB + VSB;
    const int qrow = qb * 64 + rg * 16 + fr;
    bf16x8 qf[6];
#pragma unroll
    for (int ks = 0; ks < 6; ++ks) qf[ks] = *(const bf16x8*)(Q + (size_t)qrow * 192 + ks * 32 + g4 * 8);
    f32x4 o[8];
#pragma unroll
    for (int vb = 0; vb < 8; ++vb) o[vb] = (f32x4){0.f, 0.f, 0.f, 0.f};
    float lsum = 0.f;
    u32x4 pkA[3], pvA[2], pkB[3], pvB[2];
    int krow[3], kcc[3];
#pragma unroll
    for (int i = 0; i < 3; ++i) { const int ci = tid + i * 512; krow[i] = ci / 24; kcc[i] = ci % 24; }
    const int vrow0 = tid >> 3, vcc = tid & 7;
#define ATT_LOAD(kt, pk, pv) do { _Pragma("unroll") for (int i = 0; i < 3; ++i) pk[i] = *(const u32x4*)(K + (size_t)((kt) * 64 + krow[i]) * 192 + kcc[i] * 8); \
        _Pragma("unroll") for (int i = 0; i < 2; ++i) pv[i] = *(const u32x4*)(VT + (size_t)(vrow0 + i * 64) * T + (kt) * 64 + vcc * 8); } while (0)
#define ATT_STORE(buf, pk, pv) do { unsigned char* bb = lds + (buf) * BUFB; _Pragma("unroll") for (int i = 0; i < 3; ++i) *(u32x4*)(bb + krow[i] * 400 + kcc[i] * 16) = pk[i]; \
        _Pragma("unroll") for (int i = 0; i < 2; ++i) *(u32x4*)(bb + KSB + (vrow0 + i * 64) * 144 + vcc * 16) = pv[i]; } while (0)
#define ATT_M0 24.0f
#define ATT_BODY(buf, kt) do { \
        const unsigned char* ks_ = lds + (buf) * BUFB; const unsigned char* vs_ = ks_ + KSB; \
        f32x4 s[2]; \
        _Pragma("unroll") for (int kb = 0; kb < 2; ++kb) { s[kb] = (f32x4){0.f, 0.f, 0.f, 0.f}; \
            _Pragma("unroll") for (int ks = 0; ks < 6; ++ks) { const bf16x8 kf = *(const bf16x8*)(ks_ + (kh * 32 + kb * 16 + fr) * 400 + (ks * 32 + g4 * 8) * 2); \
                s[kb] = __builtin_amdgcn_mfma_f32_16x16x32_bf16(kf, qf[ks], s[kb], 0, 0, 0); } } \
        float pe[8]; float ps = 0.f; \
        _Pragma("unroll") for (int kb = 0; kb < 2; ++kb) \
            _Pragma("unroll") for (int j = 0; j < 4; ++j) { float e = ex2(s[kb][j] - ATT_M0); \
                if ((kt) == qb) { const int key = (kt) * 64 + kh * 32 + kb * 16 + g4 * 4 + j; e = key > qrow ? 0.f : e; } pe[kb * 4 + j] = e; ps += e; } \
        lsum += ps; \
        const bf16x8 pf = as_bf16x8(pack8(pe)); \
        _Pragma("unroll") for (int vb = 0; vb < 8; ++vb) { const unsigned char* vr = vs_ + (vb * 16 + fr) * 144 + (kh * 32 + g4 * 4) * 2; \
            const u32x2 lo = *(const u32x2*)vr, hi = *(const u32x2*)(vr + 32); u32x4 vv; vv[0] = lo[0]; vv[1] = lo[1]; vv[2] = hi[0]; vv[3] = hi[1]; \
            o[vb] = __builtin_amdgcn_mfma_f32_16x16x32_bf16(as_bf16x8(vv), pf, o[vb], 0, 0, 0); } } while (0)
    ATT_LOAD(0, pkA, pvA); ATT_STORE(0, pkA, pvA);
    if (1 <= qb) ATT_LOAD(1, pkA, pvA);
    if (2 <= qb) ATT_LOAD(2, pkB, pvB);
    __syncthreads();
    for (int kt = 0; kt <= qb; kt += 2) {
        ATT_BODY(0, kt);
        if (kt + 1 <= qb) ATT_STORE(1, pkA, pvA);
        if (kt + 3 <= qb) ATT_LOAD(kt + 3, pkA, pvA);
        __syncthreads();
        if (kt + 1 > qb) break;
        ATT_BODY(1, kt + 1);
        if (kt + 2 <= qb) ATT_STORE(0, pkB, pvB);
        if (kt + 4 <= qb) ATT_LOAD(kt + 4, pkB, pvB);
        __syncthreads();
    }
#undef ATT_BODY
#undef ATT_LOAD
#undef ATT_STORE
    lsum += __shfl_xor(lsum, 16); lsum += __shfl_xor(lsum, 32);
    float* comb = (float*)(lds + 90112); float* mb = comb + 4 * 32 * 64; float* lb = mb + 256;
    if (kh == 1) {
#pragma unroll
        for (int vb = 0; vb < 8; ++vb)
#pragma unroll
            for (int j = 0; j < 4; ++j) comb[(rg * 32 + vb * 4 + j) * 64 + lane] = o[vb][j];
        lb[rg * 64 + lane] = lsum; }
    __syncthreads();
    if (kh == 0) { const float l1 = lb[rg * 64 + lane]; const float a0 = 1.0f, a1 = 1.0f;
        const float inv = 1.0f / (lsum + l1);
        bf16_t* yo = WSP(bf16_t, O_YS) + (size_t)qrow * D + 512 + h * 128 + g4 * 4;
#pragma unroll
        for (int vb = 0; vb < 8; ++vb) { float r[4];
#pragma unroll
            for (int j = 0; j < 4; ++j) r[j] = (o[vb][j] * a0 + comb[(rg * 32 + vb * 4 + j) * 64 + lane] * a1) * inv;
            u32x2 st; st[0] = pack2(r[0], r[1]); st[1] = pack2(r[2], r[3]); *(u32x2*)(yo + vb * 16) = st; } }
    __syncthreads();
}

__device__ __forceinline__ void ret_item(const Params& p, int l, unsigned char* lds, int h, int ci) {
    const int tid = tid_(), w = tid >> 6, lane = tid & 63, fr = lane & 15, g4 = lane >> 4;
    constexpr int RS = 272;
    unsigned char* Ks = lds; unsigned char* Vs = lds + 128 * RS; unsigned char* Ss = lds + 2 * 128 * RS;
    const bf16_t* RK = WSP(bf16_t, O_RK); const bf16_t* RVT = WSP(bf16_t, O_RVT); const bf16_t* SB = WSP(bf16_t, O_RSB) + (size_t)(h * 64 + ci) * 16384;
    { u32x4 tk[4], tv[4], ts[4];
#pragma unroll
      for (int i = 0; i < 4; ++i) { const int cidx = tid + i * 512, row = cidx >> 4, cc = cidx & 15;
          tk[i] = *(const u32x4*)(RK + (size_t)(ci * 128 + row) * 512 + h * 128 + cc * 8);
          tv[i] = *(const u32x4*)(RVT + (size_t)(h * 128 + row) * T + ci * 128 + cc * 8);
          ts[i] = *(const u32x4*)(SB + row * 128 + cc * 8); }
      __builtin_amdgcn_sched_barrier(0);
#pragma unroll
      for (int i = 0; i < 4; ++i) { const int cidx = tid + i * 512, row = cidx >> 4, cc = cidx & 15;
          *(u32x4*)(Ks + row * RS + cc * 16) = tk[i]; *(u32x4*)(Vs + row * RS + cc * 16) = tv[i]; *(u32x4*)(Ss + row * RS + cc * 16) = ts[i]; } }
    const int ql = w * 16 + fr, t = ci * 128 + ql;
    bf16x8 qf[4];
#pragma unroll
    for (int ks = 0; ks < 4; ++ks) qf[ks] = *(const bf16x8*)(WSP(bf16_t, O_RQ) + (size_t)t * 512 + h * 128 + ks * 32 + g4 * 8);
    __syncthreads();
    const float lg2 = ret_lg(h) * 1.4426950408889634f;
    f32x4 o[8], cr[8];
#pragma unroll
    for (int vb = 0; vb < 8; ++vb) { o[vb] = (f32x4){0.f, 0.f, 0.f, 0.f}; cr[vb] = (f32x4){0.f, 0.f, 0.f, 0.f}; }
#pragma unroll
    for (int kp = 0; kp < 4; ++kp) {
        float pe[8];
#pragma unroll
        for (int hb = 0; hb < 2; ++hb) { const int kb = kp * 2 + hb; f32x4 s = {0.f, 0.f, 0.f, 0.f};
#pragma unroll
            for (int ks = 0; ks < 4; ++ks) { const bf16x8 kf = *(const bf16x8*)(Ks + (kb * 16 + fr) * RS + (ks * 32 + g4 * 8) * 2);
                s = __builtin_amdgcn_mfma_f32_16x16x32_bf16(kf, qf[ks], s, 0, 0, 0); }
#pragma unroll
            for (int j = 0; j < 4; ++j) { const int rel = ql - (kb * 16 + g4 * 4 + j); pe[hb * 4 + j] = rel >= 0 ? s[j] * ex2(lg2 * (float)rel) : 0.f; } }
        const bf16x8 pf = as_bf16x8(pack8(pe));
#pragma unroll
        for (int vb = 0; vb < 8; ++vb) { const unsigned char* vr = Vs + (vb * 16 + fr) * RS + (kp * 32 + g4 * 4) * 2;
            const u32x2 lo = *(const u32x2*)vr, hi = *(const u32x2*)(vr + 32); u32x4 vv; vv[0] = lo[0]; vv[1] = lo[1]; vv[2] = hi[0]; vv[3] = hi[1];
            o[vb] = __builtin_amdgcn_mfma_f32_16x16x32_bf16(as_bf16x8(vv), pf, o[vb], 0, 0, 0); }
    }
#pragma unroll
    for (int vb = 0; vb < 8; ++vb)
#pragma unroll
        for (int ks = 0; ks < 4; ++ks) { const bf16x8 sf = *(const bf16x8*)(Ss + (vb * 16 + fr) * RS + (ks * 32 + g4 * 8) * 2);
            cr[vb] = __builtin_amdgcn_mfma_f32_16x16x32_bf16(sf, qf[ks], cr[vb], 0, 0, 0); }
    const bf16_t* gp = WSP(bf16_t, O_P) + (size_t)t * NINP + PRET + 1536 + h * 128 + g4 * 4;
    const float* gn = p.ret_g_norm + l * 512 + h * 128 + g4 * 4;
    u32x2 gul[8]; f32x4 gnl[8];
#pragma unroll
    for (int vb = 0; vb < 8; ++vb) { gul[vb] = *(const u32x2*)(gp + vb * 16); gnl[vb] = *(const f32x4*)(gn + vb * 16); }
    __builtin_amdgcn_sched_barrier(0);
    const float qdec = ex2(lg2 * (float)(ql + 1));
    float sum = 0.f;
#pragma unroll
    for (int vb = 0; vb < 8; ++vb) { o[vb] += qdec * cr[vb]; sum += o[vb][0] + o[vb][1] + o[vb][2] + o[vb][3]; }
    sum += __shfl_xor(sum, 16); sum += __shfl_xor(sum, 32); const float mean = sum * (1.0f / 128.0f);
    float var = 0.f;
#pragma unroll
    for (int vb = 0; vb < 8; ++vb)
#pragma unroll
        for (int j = 0; j < 4; ++j) { const float d = o[vb][j] - mean; o[vb][j] = d; var += d * d; }
    var += __shfl_xor(var, 16); var += __shfl_xor(var, 32); const float rstd = rsqrtf(var * (1.0f / 128.0f) + 1e-5f);
    bf16_t* yo = WSP(bf16_t, O_YS) + (size_t)t * D + 1024 + h * 128 + g4 * 4;
#pragma unroll
    for (int vb = 0; vb < 8; ++vb) { const u32x2 gu = gul[vb]; const f32x4 gnv = gnl[vb];
        const float gt[4] = {bflo(gu[0]), bfhi(gu[0]), bflo(gu[1]), bfhi(gu[1])}; float r[4];
#pragma unroll
        for (int j = 0; j < 4; ++j) r[j] = o[vb][j] * rstd * gnv[j] * (gt[j] * __builtin_amdgcn_rcpf(1.0f + __expf(-gt[j])));
        u32x2 st; st[0] = pack2(r[0], r[1]); st[1] = pack2(r[2], r[3]); *(u32x2*)(yo + vb * 16) = st; }
    __syncthreads();
}

__device__ __forceinline__ void rwkv_fin_head(const Params& p, int l, int b, unsigned* cnt) {
    const int tid = tid_(), h = b >> 2, q = b & 3;
    asm volatile("s_waitcnt vmcnt(0)" ::: "memory");
    __syncthreads();
    if (tid == 0) {
        __builtin_amdgcn_fence(__ATOMIC_RELEASE, "agent");
        asm volatile("s_waitcnt vmcnt(0)" ::: "memory");
        (void)__hip_atomic_fetch_add(cnt, 1u, __ATOMIC_RELAXED, __HIP_MEMORY_SCOPE_AGENT);
        unsigned sp = 0;
        while (__hip_atomic_load(cnt, __ATOMIC_RELAXED, __HIP_MEMORY_SCOPE_AGENT) < 4u) { __builtin_amdgcn_s_sleep(2); if (++sp > (1u << 22)) break; }
        __builtin_amdgcn_fence(__ATOMIC_ACQUIRE, "agent");
        asm volatile("s_waitcnt vmcnt(0)" ::: "memory");
    }
    __syncthreads();
    __builtin_amdgcn_fence(__ATOMIC_ACQUIRE, "agent");
    asm volatile("s_waitcnt vmcnt(0)" ::: "memory");
    const int tl = tid >> 3, sub = tid & 7, ch = h * 64 + sub * 8;
    const f32x4 gn0 = *(const f32x4*)(p.rwkv_g_norm + l * 512 + ch), gn1 = *(const f32x4*)(p.rwkv_g_norm + l * 512 + ch + 4);
#pragma unroll 2
    for (int it = 0; it < 32; ++it) { const int t = q * 2048 + it * 64 + tl;
        const float* op = WSP(float, O_ORAW) + (size_t)t * 512 + ch; const float* vp = WSP(float, O_RWV) + (size_t)t * 512 + ch;
        const f32x4 o0 = *(const f32x4*)op, o1 = *(const f32x4*)(op + 4), v0 = *(const f32x4*)vp, v1 = *(const f32x4*)(vp + 4);
        float g[8]; unpack8(*(const u32x4*)(WSP(bf16_t, O_LORAO) + (size_t)t * 1536 + 1024 + ch), g);
        const float bon = WSP(float, O_RWS)[(size_t)(t * 8 + h) * 4 + 2];
        float x[8] = {o0[0], o0[1], o0[2], o0[3], o1[0], o1[1], o1[2], o1[3]};
        float sm = 0.f;
#pragma unroll
        for (int i = 0; i < 8; ++i) sm += x[i];
        const float mean = row8_sum(sm) * (1.0f / 64.0f);
        float vs = 0.f;
#pragma unroll
        for (int i = 0; i < 8; ++i) { x[i] -= mean; vs += x[i] * x[i]; }
        const float rstd = rsqrtf(row8_sum(vs) * (1.0f / 64.0f) + 1e-5f);
        float r[8];
#pragma unroll
        for (int i = 0; i < 8; ++i) { const float gnv = i < 4 ? gn0[i] : gn1[i - 4]; const float vv = i < 4 ? v0[i] : v1[i - 4]; r[i] = (x[i] * rstd * gnv + bon * vv) * g[i]; }
        *(u32x4*)(WSP(bf16_t, O_YS) + (size_t)t * D + 1536 + ch) = pack8(r); }
}

__device__ __forceinline__ void phase_big(const Params& p, int l, unsigned char* lds, const XcdBarrier& xs) {
    const int b = bid_(), G = gridDim.x;
    constexpr int XS = 520;
    if (b < 32) { rwkv_scan(p, lds, b); rwkv_fin_head(p, l, b, (unsigned*)(p.ws + O_BAR) + 3456 + (l * 8 + (b >> 2)) * 32);
                  __syncthreads(); phase_convert(p, l, lds, CONV_N0, CONV_N0 + XS, false, b, 32); return; }
    const int bb = b - 32, GG = G - 32;
    { pg8::Gemm g{WSP(bf16_t, O_HBUF), WSP(bf16_t, O_WT_IN), T, G1B_N, D, D, D, 0, 0}; pg8::Sched S; S.init(T, G1B_N, GG, bb, 1);
      pg8::EpiBf16 E{WSP(bf16_t, O_P), NINP}; pg8::gemm_phase((LAS unsigned char*)lds, g, S, E); }
    __syncthreads();
    phase_convert(p, l, lds, CONV_N0 + XS, CONV_NBIG, false, bb, GG);
    xcd_barrier(xs);
    if (l == 0) phase_convert(p, 1, lds, 0, CONV_N0, false, bb, GG);
    __syncthreads();
    phase_prep1(p, l, lds, bb, GG);
    xcd_barrier(xs);
    phase_mid(p, l, lds, bb, GG);
    xcd_barrier(xs);
    phase_prep2(p, l, lds, bb, GG);
    xcd_barrier(xs);
#pragma nounroll
    for (int k = 0; k * GG < 512; ++k) { const int r = (k & 1) ? k * GG + (GG - 1 - bb) : k * GG + bb;
        if (r < 512) attn_unit(p, lds, r & 3, 127 - (r >> 2)); }
    { const int n3 = 512 - 2 * GG > 0 ? 512 - 2 * GG : 0; const int nf = GG - n3 > 0 ? GG - n3 : GG; const int j = bb - n3;
      if (j >= 0) for (int it = j; it < 256; it += nf) ret_item(p, l, lds, it >> 6, it & 63);
      else if (nf == GG) for (int it = bb; it < 256; it += GG) ret_item(p, l, lds, it >> 6, it & 63); }
}

__device__ __forceinline__ void phase_rwkvfin(const Params& p, int l) {
    const int tid = tid_(), w = tid >> 6;
    const float gn = p.rwkv_g_norm[l * 512 + tid];
#pragma unroll 4
    for (int t = blockIdx.x; t < T; t += gridDim.x) {
        const float o = WSP(float, O_ORAW)[(size_t)t * 512 + tid];
        const float mean = wave_sum(o) * (1.0f / 64.0f); const float d = o - mean; const float var = wave_sum(d * d) * (1.0f / 64.0f);
        const float bon = WSP(float, O_RWS)[(size_t)(t * 8 + w) * 4 + 2];
        const float y = (d * rsqrtf(var + 1e-5f) * gn + bon * WSP(float, O_RWV)[(size_t)t * 512 + tid]) * bf2f(WSP(bf16_t, O_LORAO)[(size_t)t * 1536 + 1024 + tid]);
        WSP(bf16_t, O_YS)[(size_t)t * D + 1536 + tid] = f2bf(y);
    }
}

constexpr int NPHASE = 23;
__global__ void __launch_bounds__(512, 2) fwd_kernel(Params pk, int lo, int hi) {
    extern __shared__ __attribute__((aligned(16))) unsigned char shm[];
    LAS unsigned char* L = (LAS unsigned char*)shm;
    const int G = gridDim.x;
    volatile LAS unsigned* xst = (volatile LAS unsigned*)(L + 131072);
    if (threadIdx.x == 0) { xst[0] = 0u; xst[1] = 0u; xst[2] = 0u; xst[3] = 0u; }
    __syncthreads();
    XcdBarrier xb = xcd_barrier_post((unsigned*)(pk.ws + O_BAR), xst, (unsigned)G);
    XcdBarrier xs; xs.total = (unsigned)(G - 32); xs.bar = (unsigned*)(pk.ws + O_BAR) + 4096; xs.x = xb.x; xs.st = xst + 2;
    if (blockIdx.x >= 32) xs = xcd_barrier_post((unsigned*)(pk.ws + O_BAR) + 4096, xst + 2, (unsigned)(G - 32));
    for (int ph = lo; ph < hi; ++ph) {
        const int b = bid_();
        Params p = pk; { unsigned long long v = (unsigned long long)pk.ws; asm volatile("" : "+s"(v)); p.ws = (unsigned char*)(__attribute__((address_space(1))) unsigned char*)v; }
        if (ph == 0) { phase_init(p, shm); phase_convert(p, 0, shm, 0, CONV_N0, true, b, G); }
        else {
            const int l = (ph - 1) / 11, s0 = (ph - 1) % 11; const int s = s0 < 6 ? s0 : s0 + 1;
            const float* mod = WSP(float, O_MOD) + l * 6 * D;
            const float* xcur = l == 0 ? p.x : WSP(float, O_XRES);
            switch (s) {
            case 0: if (l == 1) phase_convert(p, 1, shm, 0, 0, true, b, G);
                    phase_norm(p, xcur, p.norm_mix + l * D, mod + D, mod); break;
            case 1: { pg8::Gemm g{WSP(bf16_t, O_HBUF), WSP(bf16_t, O_WT_IN) + (size_t)G1B_N * D, T, NINP - G1B_N, D, D, D, 0, 0}; pg8::Sched S; S.init(T, NINP - G1B_N, G, b, 1);
                      pg8::EpiBf16 E{WSP(bf16_t, O_P) + G1B_N, NINP}; pg8::gemm_phase(L, g, S, E); } break;
            case 2: phase_r1(p, l); break;
            case 3: { pg8::Gemm g{WSP(bf16_t, O_LORAA), WSP(bf16_t, O_WT_LORA), T, 1536, 256, 256, 256, 0, 0}; pg8::Sched S; S.init(T, 1536, G, b, 1);
                      pg8::EpiBf16 E{WSP(bf16_t, O_LORAO), 1536}; pg8::gemm_phase(L, g, S, E); } break;
            case 4: phase_r3(p, l); break;
            case 5: phase_big(p, l, shm, xs); break;
            case 6: phase_rwkvfin(p, l); break;
            case 7: { pg8::Gemm g{WSP(bf16_t, O_YS), WSP(bf16_t, O_WT_BR), T, D, 512, D, 512, (size_t)512 * 2, (size_t)D * 512 * 2}; pg8::Sched S; S.init(T, D, G, b, 4);
                      pg8::EpiGate E{WSP(bf16_t, O_P), WSP(bf16_t, O_HBUF)}; pg8::gemm_phase(L, g, S, E); } break;
            case 8: { pg8::Gemm g{WSP(bf16_t, O_HBUF), WSP(bf16_t, O_WT_OUT), T, D, D, D, D, 0, 0}; pg8::Sched S; S.init(T, D, G, b, 1);
                      pg8::EpiRes E{xcur, WSP(float, O_XRES), mod + 2 * D}; pg8::gemm_phase(L, g, S, E); } break;
            case 9: phase_norm(p, WSP(float, O_XRES), p.norm_ffn + l * D, mod + 4 * D, mod + 3 * D); break;
            case 10: { pg8::Gemm g{WSP(bf16_t, O_HBUF), WSP(bf16_t, O_WT_FFI), T, 2 * FF, D, D, D, 0, 0}; pg8::Sched S; S.init(T, 2 * FF, G, b, 1);
                       pg8::EpiSwiGLU E{WSP(bf16_t, O_P)}; pg8::gemm_phase(L, g, S, E); } break;
            case 11: { pg8::Gemm g{WSP(bf16_t, O_P), WSP(bf16_t, O_WT_FFO), T, D, FF, FF, FF, 0, 0}; pg8::Sched S; S.init(T, D, G, b, 1);
                       pg8::EpiRes E{WSP(float, O_XRES), l == 1 ? p.out : WSP(float, O_XRES), mod + 5 * D}; pg8::gemm_phase(L, g, S, E); } break;
            default: break;
            }
        }
        if (ph + 1 < hi) { if (hi < 0) cg::this_grid().sync(); else xcd_barrier(xb); }
    }
}

extern "C" void kernel_launch(void* const* d_in, const int* in_sizes, int n_in, void* d_out, int out_size, void* d_ws, size_t ws_size, hipStream_t stream) {
    static int grid_blocks = 0;
    if (!grid_blocks) {
        hipFuncSetAttribute((const void*)fwd_kernel, hipFuncAttributeMaxDynamicSharedMemorySize, LDS_BYTES);
        int dev = 0, cus = 0, per_cu = 0;
        hipGetDevice(&dev);
        hipDeviceGetAttribute(&cus, hipDeviceAttributeMultiprocessorCount, dev);
        hipOccupancyMaxActiveBlocksPerMultiprocessor(&per_cu, fwd_kernel, NTHR, LDS_BYTES);
        if (per_cu < 1) per_cu = 1;
        grid_blocks = cus * (per_cu > 1 ? 1 : per_cu);
    }
    if (ws_size < O_END) { fprintf(stderr, "workspace too small: %zu < %zu\n", ws_size, (size_t)O_END); }
    Params p{};
    p.x = (const float*)d_in[0]; p.c = (const float*)d_in[1]; p.pos = (const int*)d_in[2];
    const float** fp = &p.ada_w;
    for (int i = 0; i < 33; ++i) fp[i] = (const float*)d_in[3 + i];
    p.out = (float*)d_out; p.ws = (unsigned char*)d_ws;
#if COOP
    hipMemsetAsync((unsigned char*)d_ws + O_BAR, 0, 8192 * 4, stream);
    int lo = 0, hi = NPHASE;
    void* args[] = {&p, &lo, &hi};
    hipError_t e = hipLaunchCooperativeKernel((const void*)fwd_kernel, dim3(grid_blocks), dim3(NTHR), args, LDS_BYTES, stream);
    if (e != hipSuccess) fprintf(stderr, "cooperative launch failed: %s (grid %d)\n", hipGetErrorString(e), grid_blocks);
#else
    for (int ph = 0; ph < NPHASE; ++ph) hipLaunchKernelGGL(fwd_kernel, dim3(grid_blocks), dim3(NTHR), LDS_BYTES, stream, p, ph, ph + 1);
#endif
}
```

```cpp
#include <hip/hip_runtime.h>
#include <hip/hip_cooperative_groups.h>
#include <cstdio>
namespace cg = cooperative_groups;

#ifndef COOP
#define COOP 1
#endif

#define LAS __attribute__((address_space(3)))
typedef unsigned short bf16_t;
typedef short bf16x8 __attribute__((ext_vector_type(8)));
typedef float f32x4 __attribute__((ext_vector_type(4)));
typedef float f32x2 __attribute__((ext_vector_type(2)));
typedef unsigned u32x4 __attribute__((ext_vector_type(4)));
typedef unsigned u32x2 __attribute__((ext_vector_type(2)));

constexpr int T = 8192, D = 2048, NIN = 13760, NINP = 13824, FF = 5632;
constexpr int PAX = 8192, PAG = 8704, PCQ = 9216, PCKV = 9600, PKR = 9856, PRET = 9920, PRW = 11968;
constexpr int NTHR = 512;
constexpr int LDS_BYTES = 131072 + 16;
constexpr int G1B_N = 46 * 256;

constexpr size_t al(size_t x) { return (x + 255) & ~(size_t)255; }
constexpr size_t O_WT_IN = 0;
constexpr size_t O_WT_FFI = O_WT_IN + al((size_t)NINP * D * 2);
constexpr size_t O_WT_FFO = O_WT_FFI + al((size_t)2 * FF * D * 2);
constexpr size_t O_WT_OUT = O_WT_FFO + al((size_t)D * FF * 2);
constexpr size_t O_WT_BR = O_WT_OUT + al((size_t)D * D * 2);
constexpr size_t O_WT_UQ = O_WT_BR + al((size_t)4 * D * 512 * 2);
constexpr size_t O_WT_UKV = O_WT_UQ + al((size_t)768 * 384 * 2);
constexpr size_t O_WT_LORA = O_WT_UKV + al((size_t)1024 * 256 * 2);
constexpr size_t O_MOD = O_WT_LORA + al((size_t)1536 * 256 * 2);
constexpr size_t O_COSM = O_MOD + al((size_t)2 * 6 * D * 4);
constexpr size_t O_SINM = O_COSM + al((size_t)T * 32 * 4);
constexpr size_t O_COSR = O_SINM + al((size_t)T * 32 * 4);
constexpr size_t O_SINR = O_COSR + al((size_t)T * 64 * 4);
constexpr size_t O_XRES = O_SINR + al((size_t)T * 64 * 4);
constexpr size_t O_HBUF = O_XRES + al((size_t)T * D * 4);
constexpr size_t O_P = O_HBUF + al((size_t)T * D * 2);
constexpr size_t O_YS = O_P + al((size_t)T * NINP * 2);
constexpr size_t O_HLOC = O_YS + al((size_t)T * D * 2);
constexpr size_t O_PC = O_HLOC + al((size_t)T * 512 * 4);
constexpr size_t O_TILEA = O_PC + al((size_t)T * 512 * 4);
constexpr size_t O_TILEH = O_TILEA + al((size_t)128 * 512 * 4);
constexpr size_t O_CARRY = O_TILEH + al((size_t)128 * 512 * 4);
constexpr size_t O_CQN = O_CARRY + al((size_t)128 * 512 * 4);
constexpr size_t O_CKVN = O_CQN + al((size_t)T * 384 * 2);
constexpr size_t O_QRAW = O_CKVN + al((size_t)T * 256 * 2);
constexpr size_t O_KVRAW = O_QRAW + al((size_t)T * 768 * 2);
constexpr size_t O_MQ = O_KVRAW + al((size_t)T * 1024 * 2);
constexpr size_t O_MK = O_MQ + al((size_t)4 * T * 192 * 2);
constexpr size_t O_MVT = O_MK + al((size_t)4 * T * 192 * 2);
constexpr size_t O_RQ = O_MVT + al((size_t)4 * 128 * T * 2);
constexpr size_t O_RK = O_RQ + al((size_t)T * 512 * 2);
constexpr size_t O_RKDT = O_RK + al((size_t)T * 512 * 2);
constexpr size_t O_RVT = O_RKDT + al((size_t)T * 512 * 2);
constexpr size_t O_RKV = O_RVT + al((size_t)T * 512 * 2);
constexpr size_t O_RSB = O_RKV + al((size_t)4 * 64 * 128 * 128 * 4);
constexpr size_t O_LORAA = O_RSB + al((size_t)4 * 64 * 128 * 128 * 2);
constexpr size_t O_LORAO = O_LORAA + al((size_t)T * 256 * 2);
constexpr size_t O_SCAN = O_LORAO + al((size_t)T * 1536 * 4);
constexpr size_t O_RWV = O_SCAN + al((size_t)T * 8 * 5 * 64 * 4);
constexpr size_t O_RWG = O_RWV + al((size_t)T * 512 * 4);
constexpr size_t O_RWS = O_RWG + al((size_t)T * 512 * 4);
constexpr size_t O_ORAW = O_RWS + al((size_t)T * 8 * 4 * 4);
constexpr size_t O_BAR = O_ORAW + al((size_t)T * 512 * 4);
constexpr size_t O_END = O_BAR + al((size_t)8192 * 4);

struct Params {
    const float* x; const float* c; const int* pos;
    const float *ada_w, *ada_b, *norm_mix, *norm_ffn, *w_in, *conv_w, *conv_b, *lru_wr, *lru_br, *lru_wi, *lru_bi, *lru_lam,
        *mla_g_cq, *mla_g_ckv, *mla_w_uq, *mla_w_ukv, *mla_g_qn, *mla_g_kn, *ret_g_norm, *rwkv_mu, *rwkv_w0, *rwkv_w_up, *rwkv_a0,
        *rwkv_a_up, *rwkv_g_up, *rwkv_k_k, *rwkv_k_a, *rwkv_r_k, *rwkv_g_norm, *w_branch, *w_out, *ffn_w_in, *ffn_w_out;
    float* out; unsigned char* ws;
};

__device__ __forceinline__ bf16_t f2bf(float f) { unsigned u = __float_as_uint(f); u += 0x7FFFu + ((u >> 16) & 1u); return (bf16_t)(u >> 16); }
__device__ __forceinline__ float bf2f(bf16_t b) { return __uint_as_float(((unsigned)b) << 16); }
__device__ __forceinline__ unsigned pack2(float lo, float hi) { unsigned r; asm("v_cvt_pk_bf16_f32 %0, %1, %2" : "=v"(r) : "v"(lo), "v"(hi)); return r; }
__device__ __forceinline__ float bflo(unsigned u) { return __uint_as_float(u << 16); }
__device__ __forceinline__ float bfhi(unsigned u) { return __uint_as_float(u & 0xFFFF0000u); }
__device__ __forceinline__ int tid_() { int t = threadIdx.x; asm volatile("" : "+v"(t)); return t; }
__device__ __forceinline__ int bid_() { int t = blockIdx.x; asm volatile("" : "+s"(t)); return t; }
__device__ const float INVF[64] = {1.000000000e+00f, 8.659643531e-01f, 7.498942018e-01f, 6.493816376e-01f, 5.623413324e-01f, 4.869675338e-01f, 4.216965139e-01f, 3.651741147e-01f, 3.162277639e-01f, 2.738419771e-01f, 2.371373922e-01f, 2.053525001e-01f, 1.778279394e-01f, 1.539926529e-01f, 1.333521456e-01f, 1.154782027e-01f, 1.000000015e-01f, 8.659642935e-02f, 7.498941571e-02f, 6.493816525e-02f, 5.623412877e-02f, 4.869675264e-02f, 4.216964915e-02f, 3.651741147e-02f, 3.162277862e-02f, 2.738419734e-02f, 2.371373586e-02f, 2.053524926e-02f, 1.778279431e-02f, 1.539926510e-02f, 1.333521493e-02f, 1.154781971e-02f, 9.999999776e-03f, 8.659643121e-03f, 7.498942316e-03f, 6.493816618e-03f, 5.623413250e-03f, 4.869675264e-03f, 4.216964822e-03f, 3.651741426e-03f, 3.162277862e-03f, 2.738419687e-03f, 2.371373819e-03f, 2.053525066e-03f, 1.778279431e-03f, 1.539926627e-03f, 1.333521446e-03f, 1.154781901e-03f, 1.000000047e-03f, 8.659643354e-04f, 7.498941850e-04f, 6.493816618e-04f, 5.623413017e-04f, 4.869675031e-04f, 4.216965463e-04f, 3.651741135e-04f, 3.162277862e-04f, 2.738419571e-04f, 2.371373848e-04f, 2.053525241e-04f, 1.778279402e-04f, 1.539926452e-04f, 1.333521504e-04f, 1.154782076e-04f};
__device__ __forceinline__ float ret_lg(int h) { return h == 0 ? -3.174869716e-02f : h == 1 ? -1.247911062e-02f : h == 2 ? -4.933717661e-03f : -1.955034910e-03f; }
__device__ __forceinline__ float sigmoidf_(float x) { return __builtin_amdgcn_rcpf(1.0f + __expf(-x)); }
__device__ __forceinline__ float ex2(float x) { return __builtin_amdgcn_exp2f(x); }
__device__ __forceinline__ void unpack8(u32x4 v, float* f) {
    f[0] = bflo(v[0]); f[1] = bfhi(v[0]); f[2] = bflo(v[1]); f[3] = bfhi(v[1]);
    f[4] = bflo(v[2]); f[5] = bfhi(v[2]); f[6] = bflo(v[3]); f[7] = bfhi(v[3]);
}
__device__ __forceinline__ u32x4 pack8(const float* f) {
    u32x4 r; r[0] = pack2(f[0], f[1]); r[1] = pack2(f[2], f[3]); r[2] = pack2(f[4], f[5]); r[3] = pack2(f[6], f[7]); return r;
}
__device__ __forceinline__ bf16x8 as_bf16x8(u32x4 v) { union { u32x4 a; bf16x8 b; } u; u.a = v; return u.b; }
template <int CTRL> __device__ __forceinline__ float dpp_f(float v) {
    return __int_as_float(__builtin_amdgcn_mov_dpp(__float_as_int(v), CTRL, 0xF, 0xF, true));
}
__device__ __forceinline__ float row16_sum(float v) {
    v += dpp_f<0xB1>(v);
    v += dpp_f<0x4E>(v);
    v += dpp_f<0x141>(v);
    v += dpp_f<0x140>(v);
    return v;
}

__device__ __forceinline__ float row8_sum(float v) { v += dpp_f<0xB1>(v); v += dpp_f<0x4E>(v); v += dpp_f<0x141>(v); return v; }
__device__ __forceinline__ float wave_sum(float v) {
    v = row16_sum(v); v += __shfl_xor(v, 16); v += __shfl_xor(v, 32);
    return v;
}

namespace pg8 {
constexpr int BM = 256, BK = 64, HALF = 128, HTB = HALF * BK * 2, NXCD = 8, WGM = 8;
__device__ __forceinline__ int lds_byte(int r, int c) { const int st = (r >> 4) * 2 + (c >> 5), rr = r & 15, cc = c & 31, ob = rr * 64 + cc * 2; return st * 1024 + (ob ^ (((ob >> 9) & 1) << 5)); }
__device__ __forceinline__ void stage_rc(int b, int& R, int& C) { const int st = b / 1024, sb = b % 1024, swz = sb ^ (((sb >> 9) & 1) << 5); R = (st >> 1) * 16 + swz / 64; C = (st & 1) * 32 + (swz % 64) / 2; }
__device__ __forceinline__ int perm32(int rho) { const int n = rho >> 4, i = rho & 15; return 8 * (i >> 2) + 4 * n + (i & 3); }

struct Unit { int pm, pn, z; };
struct Gemm { const bf16_t* A; const bf16_t* Bt; int M, N, K, lda, ldb; size_t azs, bzs; };
struct Sched {
    int nM, nN, nwg, G, c, nz;
    __device__ void init(int M, int N, int G_, int c_, int nz_) { nM = M / BM; nN = N / BM; nwg = nM * nN; G = G_; c = c_; nz = nz_; }
    __device__ bool next(int i, Unit& u) const {
        const int ti = i / nz; u.z = i - ti * nz;
        const long L = (long)ti * G + c; if (L >= nwg) return false;
        int wgid = (int)L; { const int q = nwg / NXCD, r = nwg % NXCD, xcd = wgid % NXCD, off = wgid / NXCD; wgid = (xcd < r ? xcd * (q + 1) : r * (q + 1) + (xcd - r) * q) + off; }
        const int nig = WGM * nN, gid = wgid / nig, fm = gid * WGM, gsz = (nM - fm) < WGM ? (nM - fm) : WGM;
        u.pm = fm + ((wgid % nig) % gsz); u.pn = (wgid % nig) / gsz; return true;
    }
};

template <class Epi>
__device__ __forceinline__ void gemm_phase(LAS unsigned char* lds, const Gemm g, const Sched& S, const Epi& E) {
    const int tid = tid_(), wid = __builtin_amdgcn_readfirstlane(tid >> 6), lane = tid & 63, wr = wid >> 2, wc = wid & 3, fr = lane & 15, fq = lane >> 4;
    const int K = g.K, nt = K / BK;
    unsigned voffA[2], voffB[2];
#pragma unroll
    for (int i = 0; i < 2; ++i) { int R, C; stage_rc(tid * 16 + i * 8192, R, C); const int Rb = Epi::PERM ? ((R & ~31) + perm32(R & 31)) : R;
        voffA[i] = (unsigned)(R * g.lda + C) * 2u; voffB[i] = (unsigned)(Rb * g.ldb + C) * 2u; }
    const size_t kstep = (size_t)(BK * 2);
    const size_t hsA = (size_t)HALF * g.lda * 2, hsB = (size_t)HALF * g.ldb * 2;
    const unsigned ldsw = (unsigned)wid * 1024u;
    const int aoff = lds_byte(wr * 64 + fr, fq * 8), boff = lds_byte(wc * 32 + fr, fq * 8);
#define PG8_SA(b, h) (((b) * 2 + (h)) * HTB)
#define PG8_SB(b, h) ((4 + (b) * 2 + (h)) * HTB)
#define PG8_STAGE(bufoff, gbase, voff) do { _Pragma("unroll") for (int _i = 0; _i < 2; ++_i) \
        __builtin_amdgcn_global_load_lds((const unsigned*)((const char*)(gbase) + (voff)[_i]), (LAS unsigned*)(lds + (bufoff) + ldsw + _i * 8192), 16, 0, 0); } while (0)
#define PG8_LDA(dst, b, h) do { _Pragma("unroll") for (int m = 0; m < 4; ++m) _Pragma("unroll") for (int k = 0; k < 2; ++k) dst[m][k] = *(const LAS bf16x8*)(lds + PG8_SA(b, h) + aoff + m * 2048 + k * 1024); } while (0)
#define PG8_LDB(dst, b, h) do { _Pragma("unroll") for (int n = 0; n < 2; ++n) _Pragma("unroll") for (int k = 0; k < 2; ++k) dst[n][k] = *(const LAS bf16x8*)(lds + PG8_SB(b, h) + boff + n * 2048 + k * 1024); } while (0)
#define PG8_MMA(ai, bj, At, Bt) do { __builtin_amdgcn_s_setprio(1); _Pragma("unroll") for (int m = 0; m < 4; ++m) _Pragma("unroll") for (int n = 0; n < 2; ++n) _Pragma("unroll") for (int k = 0; k < 2; ++k) \
        acc[ai][bj][m][n] = __builtin_amdgcn_mfma_f32_16x16x32_bf16(Bt[n][k], At[m][k], acc[ai][bj][m][n], 0, 0, 0); __builtin_amdgcn_s_setprio(0); } while (0)
#define PG8_WAIT_V(n) asm volatile("s_waitcnt vmcnt(" #n ")" ::: "memory")
#define PG8_WAIT_L(n) asm volatile("s_waitcnt lgkmcnt(" #n ")" ::: "memory")
#define PG8_BAR __builtin_amdgcn_s_barrier()
#define PG8_SCHED __builtin_amdgcn_sched_barrier(0)
    Unit cur, nxt; int ui = 0;
    if (!S.next(0, cur)) return;
    f32x4 acc[2][2][4][2];
#pragma unroll
    for (int a = 0; a < 2; ++a)
#pragma unroll
        for (int b = 0; b < 2; ++b)
#pragma unroll
            for (int m = 0; m < 4; ++m)
#pragma unroll
                for (int n = 0; n < 2; ++n) acc[a][b][m][n] = (f32x4){0.f, 0.f, 0.f, 0.f};
    bf16x8 At[4][2], B0[2][2], B1[2][2];
    const char* cA = (const char*)g.A + (size_t)cur.pm * 2 * hsA + (size_t)cur.z * g.azs;
    const char* cB = (const char*)g.Bt + (size_t)cur.pn * 2 * hsB + (size_t)cur.z * g.bzs;
    PG8_STAGE(PG8_SB(0, 0), cB, voffB); PG8_STAGE(PG8_SA(0, 0), cA, voffA); PG8_STAGE(PG8_SB(0, 1), cB + hsB, voffB); PG8_STAGE(PG8_SA(0, 1), cA + hsA, voffA);
    if (wr == 1) PG8_BAR;
    PG8_WAIT_V(4); PG8_BAR;
    PG8_STAGE(PG8_SB(1, 0), cB + kstep, voffB); PG8_STAGE(PG8_SA(1, 0), cA + kstep, voffA); PG8_STAGE(PG8_SB(1, 1), cB + hsB + kstep, voffB);
    PG8_WAIT_V(6); PG8_BAR;
    for (;;) {
        const bool has_next = S.next(ui + 1, nxt);
        const char* nA = has_next ? (const char*)g.A + (size_t)nxt.pm * 2 * hsA + (size_t)nxt.z * g.azs : cA;
        const char* nB = has_next ? (const char*)g.Bt + (size_t)nxt.pn * 2 * hsB + (size_t)nxt.z * g.bzs : cB;
        for (int t = 0; t < nt; t += 2) {
            const bool last = (t == nt - 2);
            const char* a1 = cA + (size_t)(t + 1) * kstep;
            const char* a2 = last ? nA : cA + (size_t)(t + 2) * kstep; const char* b2 = last ? nB : cB + (size_t)(t + 2) * kstep;
            const char* a3 = a2 + kstep; const char* b3 = b2 + kstep;
            PG8_LDB(B0, 0, 0); PG8_SCHED; PG8_LDA(At, 0, 0); PG8_STAGE(PG8_SA(1, 1), a1 + hsA, voffA);
            PG8_WAIT_L(8); PG8_BAR; PG8_WAIT_L(0); PG8_MMA(0, 0, At, B0); PG8_BAR; PG8_SCHED;
            PG8_LDB(B1, 0, 1); PG8_STAGE(PG8_SB(0, 0), b2, voffB);
            PG8_BAR; PG8_WAIT_L(0); PG8_MMA(0, 1, At, B1); PG8_BAR;
            PG8_LDA(At, 0, 1); PG8_STAGE(PG8_SA(0, 0), a2, voffA);
            PG8_BAR; PG8_WAIT_L(0); PG8_MMA(1, 0, At, B0); PG8_BAR; PG8_SCHED;
            PG8_STAGE(PG8_SB(0, 1), b2 + hsB, voffB);
            PG8_WAIT_V(6); PG8_BAR; PG8_MMA(1, 1, At, B1); PG8_BAR;
            PG8_LDB(B0, 1, 0); PG8_SCHED; PG8_LDA(At, 1, 0); PG8_STAGE(PG8_SA(0, 1), a2 + hsA, voffA);
            PG8_WAIT_L(8); PG8_BAR; PG8_WAIT_L(0); PG8_MMA(0, 0, At, B0); PG8_BAR; PG8_SCHED;
            PG8_LDB(B1, 1, 1); PG8_STAGE(PG8_SB(1, 0), b3, voffB);
            PG8_BAR; PG8_WAIT_L(0); PG8_MMA(0, 1, At, B1); PG8_BAR;
            PG8_LDA(At, 1, 1); PG8_STAGE(PG8_SA(1, 0), a3, voffA);
            PG8_BAR; PG8_WAIT_L(0); PG8_MMA(1, 0, At, B0); PG8_BAR; PG8_SCHED;
            PG8_STAGE(PG8_SB(1, 1), b3 + hsB, voffB);
            PG8_WAIT_V(6); PG8_BAR; PG8_MMA(1, 1, At, B1); PG8_BAR;
        }
        const bool zero = E(acc, cur, wr, wc, fr, fq);
        if (!has_next) break;
        if (zero) {
#pragma unroll
            for (int a = 0; a < 2; ++a)
#pragma unroll
                for (int b = 0; b < 2; ++b)
#pragma unroll
                    for (int m = 0; m < 4; ++m)
#pragma unroll
                        for (int n = 0; n < 2; ++n) acc[a][b][m][n] = (f32x4){0.f, 0.f, 0.f, 0.f};
        }
        cur = nxt; cA = nA; cB = nB; ++ui;
    }
    PG8_WAIT_V(0);
    if (wr == 0) PG8_BAR;
    PG8_BAR;
#undef PG8_SA
#undef PG8_SB
#undef PG8_STAGE
#undef PG8_LDA
#undef PG8_LDB
#undef PG8_MMA
#undef PG8_WAIT_V
#undef PG8_WAIT_L
#undef PG8_BAR
#undef PG8_SCHED
}

typedef f32x4 Acc[2][2][4][2];
struct EpiBf16 {
    static constexpr bool PERM = true;
    bf16_t* O; int ldc;
    __device__ __forceinline__ bool operator()(Acc& acc, const Unit& u, int wr, int wc, int fr, int fq) const {
        const int row0 = u.pm * BM + wr * 64 + fr, col0 = u.pn * BM + wc * 32 + 8 * fq;
#pragma unroll
        for (int ai = 0; ai < 2; ++ai)
#pragma unroll
            for (int m = 0; m < 4; ++m) { bf16_t* rowp = O + (size_t)(row0 + ai * HALF + m * 16) * ldc + col0;
#pragma unroll
                for (int bj = 0; bj < 2; ++bj) { const f32x4 v0 = acc[ai][bj][m][0], v1 = acc[ai][bj][m][1];
                    u32x4 o; o[0] = pack2(v0[0], v0[1]); o[1] = pack2(v0[2], v0[3]); o[2] = pack2(v1[0], v1[1]); o[3] = pack2(v1[2], v1[3]);
                    *(u32x4*)(rowp + bj * HALF) = o; } }
        return true;
    }
};
struct EpiF32 {
    static constexpr bool PERM = false;
    float* C; int ldc;
    __device__ __forceinline__ bool operator()(Acc& acc, const Unit& u, int wr, int wc, int fr, int fq) const {
        const int row0 = u.pm * BM + wr * 64 + fr, col0 = u.pn * BM + wc * 32 + 4 * fq;
#pragma unroll
        for (int ai = 0; ai < 2; ++ai)
#pragma unroll
            for (int m = 0; m < 4; ++m) { float* rowp = C + (size_t)(row0 + ai * HALF + m * 16) * ldc + col0;
#pragma unroll
                for (int bj = 0; bj < 2; ++bj)
#pragma unroll
                    for (int n = 0; n < 2; ++n) *(f32x4*)(rowp + bj * HALF + n * 16) = acc[ai][bj][m][n]; }
        return true;
    }
};
struct EpiRes {
    static constexpr bool PERM = false;
    const float* xin; float* xout; const float* gate;
    __device__ __forceinline__ bool operator()(Acc& acc, const Unit& u, int wr, int wc, int fr, int fq) const {
        const int row0 = u.pm * BM + wr * 64 + fr, col0 = u.pn * BM + wc * 32 + 4 * fq;
        f32x4 gv[2][2];
#pragma unroll
        for (int bj = 0; bj < 2; ++bj)
#pragma unroll
            for (int n = 0; n < 2; ++n) gv[bj][n] = *(const f32x4*)(gate + col0 + bj * HALF + n * 16);
#pragma unroll
        for (int ai = 0; ai < 2; ++ai)
#pragma unroll
            for (int mp = 0; mp < 2; ++mp) {
                f32x4 xi[2][2][2];
#pragma unroll
                for (int mm = 0; mm < 2; ++mm) { const size_t ro = (size_t)(row0 + ai * HALF + (mp * 2 + mm) * 16) * D + col0;
#pragma unroll
                    for (int bj = 0; bj < 2; ++bj)
#pragma unroll
                        for (int n = 0; n < 2; ++n) xi[mm][bj][n] = *(const f32x4*)(xin + ro + bj * HALF + n * 16); }
                __builtin_amdgcn_sched_barrier(0);
#pragma unroll
                for (int mm = 0; mm < 2; ++mm) { const int m = mp * 2 + mm; const size_t ro = (size_t)(row0 + ai * HALF + m * 16) * D + col0;
#pragma unroll
                    for (int bj = 0; bj < 2; ++bj)
#pragma unroll
                        for (int n = 0; n < 2; ++n) *(f32x4*)(xout + ro + bj * HALF + n * 16) = xi[mm][bj][n] + gv[bj][n] * acc[ai][bj][m][n]; }
                __builtin_amdgcn_sched_barrier(0); }
        return true;
    }
};
struct EpiSwiGLU {
    static constexpr bool PERM = true;
    bf16_t* O;
    __device__ __forceinline__ bool operator()(Acc& acc, const Unit& u, int wr, int wc, int fr, int fq) const {
        const int row0 = u.pm * BM + wr * 64 + fr, col0 = u.pn * HALF + wc * 32 + 8 * fq;
#pragma unroll
        for (int ai = 0; ai < 2; ++ai)
#pragma unroll
            for (int m = 0; m < 4; ++m) { bf16_t* rowp = O + (size_t)(row0 + ai * HALF + m * 16) * FF + col0;
                float r[8];
#pragma unroll
                for (int n = 0; n < 2; ++n)
#pragma unroll
                    for (int i = 0; i < 4; ++i) { const float gt = acc[ai][0][m][n][i], vl = acc[ai][1][m][n][i]; r[n * 4 + i] = gt * __builtin_amdgcn_rcpf(1.0f + __expf(-gt)) * vl; }
                *(u32x4*)rowp = pack8(r); }
        return true;
    }
};
struct EpiGate {
    static constexpr bool PERM = true;
    const bf16_t* P; bf16_t* O;
    __device__ __forceinline__ bool operator()(Acc& acc, const Unit& u, int wr, int wc, int fr, int fq) const {
        const int row0 = u.pm * BM + wr * 64 + fr, col0 = u.pn * BM + wc * 32 + 8 * fq;
        const int z1 = u.z < 3 ? u.z + 1 : u.z;
#pragma unroll
        for (int ai = 0; ai < 2; ++ai)
#pragma unroll
            for (int bj = 0; bj < 2; ++bj) { const int col = col0 + bj * HALF;
                u32x4 LZ[4], L1[4];
#pragma unroll
                for (int m = 0; m < 4; ++m) { const bf16_t* rp = P + (size_t)(row0 + ai * HALF + m * 16) * NINP + col;
                    LZ[m] = *(const u32x4*)(rp + u.z * D); L1[m] = *(const u32x4*)(rp + z1 * D); }
                __builtin_amdgcn_sched_barrier(0);
#pragma unroll
                for (int m = 0; m < 4; ++m) { const int row = row0 + ai * HALF + m * 16;
                    float lz[8], l1[8], fac[8]; unpack8(LZ[m], lz); unpack8(L1[m], l1);
                    if (u.z < 3) {
#pragma unroll
                        for (int i = 0; i < 8; ++i) fac[i] = (1.0f + __expf(-l1[i])) * __builtin_amdgcn_rcpf(1.0f + __expf(-lz[i])); }
                    else {
#pragma unroll
                        for (int i = 0; i < 8; ++i) fac[i] = __builtin_amdgcn_rcpf(1.0f + __expf(-lz[i])); }
#pragma unroll
                    for (int n = 0; n < 2; ++n)
#pragma unroll
                        for (int i = 0; i < 4; ++i) acc[ai][bj][m][n][i] *= fac[n * 4 + i];
                    if (u.z == 3) { float r[8];
#pragma unroll
                        for (int n = 0; n < 2; ++n)
#pragma unroll
                            for (int i = 0; i < 4; ++i) r[n * 4 + i] = acc[ai][bj][m][n][i];
                        *(u32x4*)(O + (size_t)row * D + col) = pack8(r); } }
                __builtin_amdgcn_sched_barrier(0); }
        return u.z == 3;
    }
};
}

#define XB_TMO      128
#define XB_XCNT(j)  (256  + 64 * (j))
#define XB_XSUB(j)  (1280 + 64 * (j))
#define XB_XGEN(j)  (2304 + 64 * (j))
#define XB_TOP      3328
#define XB_TOPGEN   3392
#define XCD_BAR_WORDS 3456
#define XB_SPIN_CAP (1u << 18)

__device__ __forceinline__ unsigned xb_ld(unsigned* p)              { return __hip_atomic_load(p, __ATOMIC_RELAXED, __HIP_MEMORY_SCOPE_AGENT); }
__device__ __forceinline__ unsigned xb_add(unsigned* p, unsigned v) { return __hip_atomic_fetch_add(p, v, __ATOMIC_RELAXED, __HIP_MEMORY_SCOPE_AGENT); }
__device__ __forceinline__ unsigned xb_xcc_id() { return (unsigned)__builtin_amdgcn_s_getreg((3 << 11) | 20) & 0xFu; }
#define XB_SPIN(cond, bar) do { unsigned _sp = 0; while (cond) { __builtin_amdgcn_s_sleep(1); \
    if ((++_sp & 255u) == 0u) { if (xb_ld(&(bar)[XB_TMO])) break; if (_sp > XB_SPIN_CAP) { atomicAdd(&(bar)[XB_TMO], 1u); break; } } } } while (0)

struct XcdBarrier {
    unsigned total;
    unsigned* bar; unsigned x;
    volatile LAS unsigned* st;
};

__device__ __forceinline__ XcdBarrier xcd_barrier_post(unsigned* bar, volatile LAS unsigned* st, unsigned total) {
    XcdBarrier b; b.total = total; b.bar = bar; b.x = xb_xcc_id(); b.st = st;
    if (threadIdx.x == 0) (void)xb_add(&bar[XB_XCNT(b.x)], 1u);
    return b;
}
__device__ __forceinline__ void xcd_barrier_complete(unsigned* bar, unsigned x, unsigned& nloc, unsigned& nx, unsigned G) {
    unsigned sum, cnt, mine, sp = 0u;
    for (;;) {
        sum = 0u; cnt = 0u; mine = 0u;
#pragma unroll
        for (unsigned j = 0; j < 16; ++j) { const unsigned c = xb_ld(&bar[XB_XCNT(j)]); sum += c; cnt += (c > 0u) ? 1u : 0u; mine = (j == x) ? c : mine; }
        if (sum == G) break;
        __builtin_amdgcn_s_sleep(1);
        if ((++sp & 255u) == 0u) { if (xb_ld(&bar[XB_TMO])) break; if (sp > XB_SPIN_CAP) { atomicAdd(&bar[XB_TMO], 1u); break; } }
    }
    nloc = mine > 0u ? mine : 1u; nx = cnt > 0u ? cnt : 1u;
}

__device__ __forceinline__ void xcd_barrier(const XcdBarrier& b) {
    asm volatile("s_waitcnt vmcnt(0)" ::: "memory");
    __syncthreads();
    if (threadIdx.x == 0) {
        unsigned* bar = b.bar;
        __builtin_amdgcn_s_waitcnt(0);
        unsigned nloc = b.st[0], nx = b.st[1];
        if (nloc == 0u) { xcd_barrier_complete(bar, b.x, nloc, nx, b.total); b.st[0] = nloc; b.st[1] = nx; }
        const unsigned old = xb_add(&bar[XB_XSUB(b.x)], 1u);
        const unsigned gen = old / nloc;
        if (old + 1u == (gen + 1u) * nloc) {
            __builtin_amdgcn_fence(__ATOMIC_RELEASE, "agent");
            asm volatile("s_waitcnt vmcnt(0)" ::: "memory");
            const unsigned og = xb_add(&bar[XB_TOP], 1u);
            const unsigned tg = og / nx;
            if (og + 1u == (tg + 1u) * nx) xb_add(&bar[XB_TOPGEN], 1u);
            else XB_SPIN(xb_ld(&bar[XB_TOPGEN]) == tg, bar);
            __builtin_amdgcn_fence(__ATOMIC_ACQUIRE, "agent");
            xb_add(&bar[XB_XGEN(b.x)], 1u);
            asm volatile("s_waitcnt vmcnt(0)" ::: "memory");
        } else {
            XB_SPIN(xb_ld(&bar[XB_XGEN(b.x)]) == gen, bar);
            __builtin_amdgcn_fence(__ATOMIC_ACQUIRE, "agent");
            asm volatile("s_waitcnt vmcnt(0)" ::: "memory");
        }
    }
    __syncthreads();
}


#define WSP(type, off) ((type*)(p.ws + (off)))

__device__ __forceinline__ void conv_tile(float* tile, const float* src, int ldsrc, int k0, int n0, int nvalid, bf16_t* dst, int lddst, int kd0, int drow0, const float* kscale) {
    const int tid = tid_();
    { const int nn = tid & 63, kq = tid >> 6;
#pragma unroll
      for (int i = 0; i < 8; ++i) { const int kk = i * 8 + kq; const int n = n0 + nn; float v = 0.f;
          if (src && n < nvalid) { v = src[(size_t)(k0 + kk) * ldsrc + n]; if (kscale) v *= kscale[k0 + kk]; }
          tile[kk * 65 + nn] = v; } }
    __syncthreads();
    { const int kp = tid & 31, nq = tid >> 5;
#pragma unroll
      for (int i = 0; i < 4; ++i) { const int nn = i * 16 + nq; const float v0 = tile[(2 * kp) * 65 + nn], v1 = tile[(2 * kp + 1) * 65 + nn];
          *(unsigned*)(dst + (size_t)(drow0 + nn) * lddst + kd0 + 2 * kp) = pack2(v0, v1); } }
    __syncthreads();
}

struct ConvT { const float* src; bf16_t* dst; int ldsrc, lddst, nvalid; };
__device__ __forceinline__ ConvT conv_decode(const Params& p, int l, int i) {
    ConvT t; t.nvalid = 1 << 30;
    constexpr int N0 = 216 * 16, N1 = 176 * 16, N2 = 32 * 44, N3 = 32 * 16;
    if (i < N0) { const int nt = i >> 4, kt = i & 15; t.src = p.w_in + (size_t)l * D * NIN + (size_t)kt * 128 * NIN + nt * 64; t.ldsrc = NIN;
        t.dst = WSP(bf16_t, O_WT_IN) + (size_t)nt * 64 * D + kt * 128; t.lddst = D; t.nvalid = NIN - nt * 64; return t; }
    i -= N0;
    if (i < N1) { const int nt = i >> 4, kt = i & 15; const int c0 = nt * 64;
        int drow; if (c0 < FF) drow = 256 * (c0 >> 7) + (c0 & 127); else { const int j = c0 - FF; drow = 256 * (j >> 7) + 128 + (j & 127); }
        t.src = p.ffn_w_in + (size_t)l * D * 2 * FF + (size_t)kt * 128 * 2 * FF + c0; t.ldsrc = 2 * FF; t.dst = WSP(bf16_t, O_WT_FFI) + (size_t)drow * D + kt * 128; t.lddst = D; return t; }
    i -= N1;
    if (i < N2) { const int nt = i / 44, kt = i % 44; t.src = p.ffn_w_out + (size_t)l * FF * D + (size_t)kt * 128 * D + nt * 64; t.ldsrc = D;
        t.dst = WSP(bf16_t, O_WT_FFO) + (size_t)nt * 64 * FF + kt * 128; t.lddst = FF; return t; }
    i -= N2;
    if (i < N3) { const int nt = i >> 4, kt = i & 15; t.src = p.w_out + (size_t)l * D * D + (size_t)kt * 128 * D + nt * 64; t.ldsrc = D;
        t.dst = WSP(bf16_t, O_WT_OUT) + (size_t)nt * 64 * D + kt * 128; t.lddst = D; return t; }
    i -= N3;
    { const int z = i >> 7, r = i & 127, nt = r >> 2, kt = r & 3; t.src = p.w_branch + ((size_t)l * 4 + z) * 512 * D + (size_t)kt * 128 * D + nt * 64; t.ldsrc = D;
      t.dst = WSP(bf16_t, O_WT_BR) + (size_t)z * D * 512 + (size_t)nt * 64 * 512 + kt * 128; t.lddst = 512; return t; }
}
constexpr int CONV_N0 = 216 * 16, CONV_NBIG = 216 * 16 + 176 * 16 + 32 * 44 + 32 * 16 + 4 * 32 * 4;
__device__ __forceinline__ void phase_convert(const Params& p, int l, unsigned char* lds, int i0, int NBIG, bool do_small, int bb, int G) {
    float* tile = (float*)lds;
    const int tid = tid_();
    if (i0 < NBIG) {
        const int n4 = tid & 15, kq = tid >> 4, nn = tid & 63, kp = tid >> 6;
        f32x4 r[4];
        int it = i0 + bb;
        ConvT cur = conv_decode(p, l, it < NBIG ? it : 0);
        if (it < NBIG) {
#pragma unroll
            for (int i = 0; i < 4; ++i) r[i] = (n4 * 4 < cur.nvalid) ? __builtin_nontemporal_load((const f32x4*)(cur.src + (size_t)(i * 32 + kq) * cur.ldsrc + n4 * 4)) : (f32x4){0.f, 0.f, 0.f, 0.f};
        }
        while (it < NBIG) {
#pragma unroll
            for (int i = 0; i < 4; ++i) *(f32x4*)(tile + (i * 32 + kq) * 68 + n4 * 4) = r[i];
            __syncthreads();
            const int itn = it + G; const ConvT nx = conv_decode(p, l, itn < NBIG ? itn : 0);
            if (itn < NBIG) {
#pragma unroll
                for (int i = 0; i < 4; ++i) r[i] = (n4 * 4 < nx.nvalid) ? __builtin_nontemporal_load((const f32x4*)(nx.src + (size_t)(i * 32 + kq) * nx.ldsrc + n4 * 4)) : (f32x4){0.f, 0.f, 0.f, 0.f};
            }
            float v[16];
#pragma unroll
            for (int j = 0; j < 16; ++j) v[j] = tile[(kp * 16 + j) * 68 + nn];
            bf16_t* d = cur.dst + (size_t)nn * cur.lddst + kp * 16;
            *(u32x4*)d = pack8(v); *(u32x4*)(d + 8) = pack8(v + 8);
            __syncthreads();
            cur = nx; it = itn;
        }
    }
    constexpr int N5 = 12 * 6, N6 = 16 * 4, N7 = 24 * 4;
    if (do_small)
    for (int it = bb; it < N5 + N6 + N7; it += G) {
        int i = it;
        if (i < N5) { const int nt = i / 6, kt = i % 6;
            conv_tile(tile, p.mla_w_uq + (size_t)l * 384 * 768, 768, kt * 64, nt * 64, 768, WSP(bf16_t, O_WT_UQ), 384, kt * 64, nt * 64, p.mla_g_cq + l * 384); continue; }
        i -= N5;
        if (i < N6) { const int nt = i >> 2, kt = i & 3;
            conv_tile(tile, p.mla_w_ukv + (size_t)l * 256 * 1024, 1024, kt * 64, nt * 64, 1024, WSP(bf16_t, O_WT_UKV), 256, kt * 64, nt * 64, p.mla_g_ckv + l * 256); continue; }
        i -= N6;
        { const int nt = i >> 2, kt = i & 3;
          const float* src = nullptr; int k0 = 0, n0 = (nt & 7) * 64;
          if (nt < 8) { if (kt == 0) { src = p.rwkv_w_up + (size_t)l * 64 * 512; k0 = 0; } }
          else if (nt < 16) { if (kt == 1) { src = p.rwkv_a_up + (size_t)l * 64 * 512; k0 = 0; } }
          else { if (kt >= 2) { src = p.rwkv_g_up + (size_t)l * 128 * 512; k0 = (kt - 2) * 64; } }
          conv_tile(tile, src, 512, k0, n0, 512, WSP(bf16_t, O_WT_LORA), 256, kt * 64, nt * 64, nullptr); }
    }
}

__device__ __forceinline__ void phase_init(const Params& p, unsigned char* lds) {
    const int tid = tid_(), G = gridDim.x, w = tid >> 6, lane = tid & 63;
    float* cact = (float*)lds; float* red = cact + D;
    for (int it = blockIdx.x; it < 192; it += G) {
        const int l = it / 96, cgp = it % 96;
        for (int i = tid; i < D; i += NTHR) { const float cv = p.c[i]; cact[i] = cv / (1.0f + __expf(-cv)); }
        __syncthreads();
        const int sub = lane >> 5, cl = (lane & 31) * 4;
        f32x4 a = {0.f, 0.f, 0.f, 0.f};
        const float* wb = p.ada_w + (size_t)l * D * 6 * D + cgp * 128 + cl;
        for (int kk = 0; kk < 128; ++kk) { const int k = w * 256 + kk * 2 + sub; const f32x4 wv = __builtin_nontemporal_load((const f32x4*)(wb + (size_t)k * 6 * D)); a += cact[k] * wv; }
        *(f32x4*)(red + (w * 2 + sub) * 128 + cl) = a;
        __syncthreads();
        if (tid < 128) { float s = p.ada_b[l * 6 * D + cgp * 128 + tid];
#pragma unroll
            for (int j = 0; j < 16; ++j) s += red[j * 128 + tid];
            WSP(float, O_MOD)[l * 6 * D + cgp * 128 + tid] = s; }
        __syncthreads();
    }
    for (int idx = blockIdx.x * NTHR + tid; idx < T * 96; idx += G * NTHR) {
        const int t = idx / 96, j = idx % 96; const int dim = j < 32 ? 64 : 128, i = j < 32 ? j : j - 32;
        const float inv = INVF[j < 32 ? 2 * i : i];
        const float ang = (float)p.pos[t] * inv;
        const float kq = rintf(ang * 0.15915494309189535f);
        float rr = fmaf(-kq, 6.28125f, ang); rr = fmaf(-kq, 0.0019350051879882812f, rr); rr = fmaf(-kq, 3.019916e-07f, rr);
        const float rev = rr * 0.15915494309189535f; const float cs = __builtin_amdgcn_cosf(rev), sn = __builtin_amdgcn_sinf(rev);
        if (j < 32) { WSP(float, O_COSM)[t * 32 + i] = cs; WSP(float, O_SINM)[t * 32 + i] = sn; }
        else { WSP(float, O_COSR)[t * 64 + i] = cs; WSP(float, O_SINR)[t * 64 + i] = sn; }
    }
}

__device__ __forceinline__ void phase_norm(const Params& p, const float* xsrc, const float* gw, const float* scale, const float* shift) {
    const int tid = tid_(), w = tid >> 6, lane = tid & 63;
    bf16_t* hb = WSP(bf16_t, O_HBUF);
    f32x4 cf[8], shv[8];
#pragma unroll
    for (int i = 0; i < 8; ++i) { const int c = (i * 64 + lane) * 4; const f32x4 gg = *(const f32x4*)(gw + c), sc = *(const f32x4*)(scale + c); cf[i] = gg * (1.0f + sc); shv[i] = *(const f32x4*)(shift + c); }
    __builtin_amdgcn_sched_barrier(0);
    for (int row = blockIdx.x * 8 + w; row < T; row += gridDim.x * 8) {
        const float* xr = xsrc + (size_t)row * D; f32x4 v[8]; float ss = 0.f;
#pragma unroll
        for (int i = 0; i < 8; ++i) v[i] = *(const f32x4*)(xr + (i * 64 + lane) * 4);
        __builtin_amdgcn_sched_barrier(0);
#pragma unroll
        for (int i = 0; i < 8; ++i) ss += v[i][0] * v[i][0] + v[i][1] * v[i][1] + v[i][2] * v[i][2] + v[i][3] * v[i][3];
        ss = wave_sum(ss); const float rs = rsqrtf(ss * (1.0f / D) + 1e-6f);
#pragma unroll
        for (int i = 0; i < 8; ++i) { const int c = (i * 64 + lane) * 4;
            float o[4];
#pragma unroll
            for (int j = 0; j < 4; ++j) o[j] = v[i][j] * rs * cf[i][j] + shv[i][j];
            u32x2 st; st[0] = pack2(o[0], o[1]); st[1] = pack2(o[2], o[3]); *(u32x2*)(hb + (size_t)row * D + c) = st; }
    }
}

__device__ __forceinline__ void phase_prep1(const Params& p, int l, unsigned char* lds, int bb, int G) {
    const int tid = tid_(), w = tid >> 6, lane = tid & 63;
    const bf16_t* P = WSP(bf16_t, O_P);
    {
        float* xa = (float*)lds; float* wrs = xa + 64 * 65; float* wis = wrs + 4096; float* As = wis + 4096; float* Us = As + 64 * 65;
        for (int it = bb; it < 1024; it += G) {
            const int tt = it >> 3, n = it & 7; const int c = tid & 63, tg = tid >> 6, cc = n * 64 + c;
            { const float cw0 = p.conv_w[(l * 4 + 0) * 512 + cc], cw1 = p.conv_w[(l * 4 + 1) * 512 + cc], cw2 = p.conv_w[(l * 4 + 2) * 512 + cc], cw3 = p.conv_w[(l * 4 + 3) * 512 + cc], cb = p.conv_b[l * 512 + cc];
              { float xv[11]; const int tb = tt * 64 + tg * 8 - 3;
#pragma unroll
                for (int j = 0; j < 11; ++j) { const int tj = tb + j; const float x = bf2f(P[(size_t)(tj < 0 ? 0 : tj) * NINP + PAX + cc]); xv[j] = tj < 0 ? 0.f : x; }
                __builtin_amdgcn_sched_barrier(0);
#pragma unroll
                for (int i = 0; i < 8; ++i) xa[(tg * 8 + i) * 65 + c] = cb + cw0 * xv[i] + cw1 * xv[i + 1] + cw2 * xv[i + 2] + cw3 * xv[i + 3]; }
#pragma unroll
              for (int i = 0; i < 8; ++i) { const int e = i * 512 + tid; wrs[e] = p.lru_wr[((size_t)l * 8 + n) * 4096 + e]; wis[e] = p.lru_wi[((size_t)l * 8 + n) * 4096 + e]; } }
            __syncthreads();
            { float ra[8], ia[8];
#pragma unroll
              for (int k = 0; k < 8; ++k) { ra[k] = 0.f; ia[k] = 0.f; }
              for (int i = 0; i < 64; ++i) { const float wv = wrs[i * 64 + c], wi = wis[i * 64 + c];
#pragma unroll
                  for (int k = 0; k < 8; ++k) { const float xv = xa[(tg * 8 + k) * 65 + i]; ra[k] += xv * wv; ia[k] += xv * wi; } }
              const float br = p.lru_br[l * 512 + cc], bi = p.lru_bi[l * 512 + cc], lam = p.lru_lam[l * 512 + cc];
              const float sp = log1pf(__expf(-lam));
#pragma unroll
              for (int k = 0; k < 8; ++k) { const float r = sigmoidf_(ra[k] + br), ig = sigmoidf_(ia[k] + bi);
                  const float log_a = -8.0f * sp * r; const float a = __expf(log_a);
                  const float u = sqrtf(-expm1f(2.0f * log_a)) * (ig * xa[(tg * 8 + k) * 65 + c]);
                  As[(tg * 8 + k) * 65 + c] = a; Us[(tg * 8 + k) * 65 + c] = u; } }
            __syncthreads();
            {
              float hl8[8], pl8[8]; float h = 0.f, pr = 1.f;
#pragma unroll
              for (int i = 0; i < 8; ++i) { const float a = As[(tg * 8 + i) * 65 + c]; h = a * h + Us[(tg * 8 + i) * 65 + c]; pr *= a; hl8[i] = h; pl8[i] = pr; }
              float* segA = wrs; float* segH = wrs + 512;
              segA[tg * 64 + c] = pr; segH[tg * 64 + c] = h;
              __syncthreads();
              float carry = 0.f, pin = 1.f;
              for (int s2 = 0; s2 < tg; ++s2) { const float a = segA[s2 * 64 + c]; carry = a * carry + segH[s2 * 64 + c]; pin *= a; }
              float* hlg = WSP(float, O_HLOC) + (size_t)(tt * 64 + tg * 8) * 512 + cc; float* pcg = WSP(float, O_PC) + (size_t)(tt * 64 + tg * 8) * 512 + cc;
#pragma unroll
              for (int i = 0; i < 8; ++i) { hlg[(size_t)i * 512] = hl8[i] + pl8[i] * carry; pcg[(size_t)i * 512] = pl8[i] * pin; }
              if (tg == 7) { WSP(float, O_TILEA)[tt * 512 + cc] = pl8[7] * pin; WSP(float, O_TILEH)[tt * 512 + cc] = hl8[7] + pl8[7] * carry; } }
            __syncthreads();
        }
    }
    for (int t = bb * 8 + w; t < T; t += G * 8) {
        const bf16_t* pr = P + (size_t)t * NINP;
        unsigned q[3]; float ss = 0.f;
#pragma unroll
        for (int i = 0; i < 3; ++i) { q[i] = *(const unsigned*)(pr + PCQ + (i * 64 + lane) * 2); const float a = bflo(q[i]), b = bfhi(q[i]); ss += a * a + b * b; }
        ss = wave_sum(ss); float rs = rsqrtf(ss * (1.0f / 384.0f) + 1e-6f);
#pragma unroll
        for (int i = 0; i < 3; ++i) *(unsigned*)(WSP(bf16_t, O_CQN) + (size_t)t * 384 + (i * 64 + lane) * 2) = pack2(bflo(q[i]) * rs, bfhi(q[i]) * rs);
        unsigned kv[2]; ss = 0.f;
#pragma unroll
        for (int i = 0; i < 2; ++i) { kv[i] = *(const unsigned*)(pr + PCKV + (i * 64 + lane) * 2); const float a = bflo(kv[i]), b = bfhi(kv[i]); ss += a * a + b * b; }
        ss = wave_sum(ss); rs = rsqrtf(ss * (1.0f / 256.0f) + 1e-6f);
#pragma unroll
        for (int i = 0; i < 2; ++i) *(unsigned*)(WSP(bf16_t, O_CKVN) + (size_t)t * 256 + (i * 64 + lane) * 2) = pack2(bflo(kv[i]) * rs, bfhi(kv[i]) * rs);
    }
    {
        bf16_t* tl = (bf16_t*)lds;
        const float* cosr = WSP(float, O_COSR); const float* sinr = WSP(float, O_SINR);
        for (int it = bb; it < 512; it += G) {
            const int tt = it >> 2, h = it & 3; const int tloc = tid >> 3, seg = tid & 7; const int t = tt * 64 + tloc;
            const float lg = ret_lg(h);
            const float kdec = __expf(lg * (float)(127 - (t & 127)));
            float cs[8], sn[8];
            { const f32x4 c0 = *(const f32x4*)(cosr + t * 64 + seg * 8), c1 = *(const f32x4*)(cosr + t * 64 + seg * 8 + 4), s0 = *(const f32x4*)(sinr + t * 64 + seg * 8), s1 = *(const f32x4*)(sinr + t * 64 + seg * 8 + 4);
#pragma unroll
              for (int i = 0; i < 4; ++i) { cs[i] = c0[i]; cs[4 + i] = c1[i]; sn[i] = s0[i]; sn[4 + i] = s1[i]; } }
            const bf16_t* pr = P + (size_t)t * NINP + PRET + h * 128 + seg * 8;
            float x1[8], x2[8], o1[8], o2[8];
            unpack8(*(const u32x4*)(pr), x1); unpack8(*(const u32x4*)(pr + 64), x2);
#pragma unroll
            for (int i = 0; i < 8; ++i) { o1[i] = x1[i] * cs[i] - x2[i] * sn[i]; o2[i] = x1[i] * sn[i] + x2[i] * cs[i]; }
            *(u32x4*)(WSP(bf16_t, O_RQ) + (size_t)t * 512 + h * 128 + seg * 8) = pack8(o1);
            *(u32x4*)(WSP(bf16_t, O_RQ) + (size_t)t * 512 + h * 128 + 64 + seg * 8) = pack8(o2);
            unpack8(*(const u32x4*)(pr + 512), x1); unpack8(*(const u32x4*)(pr + 512 + 64), x2);
#pragma unroll
            for (int i = 0; i < 8; ++i) { o1[i] = (x1[i] * cs[i] - x2[i] * sn[i]) * 0.08838834764831845f; o2[i] = (x1[i] * sn[i] + x2[i] * cs[i]) * 0.08838834764831845f; }
            *(u32x4*)(WSP(bf16_t, O_RK) + (size_t)t * 512 + h * 128 + seg * 8) = pack8(o1);
            *(u32x4*)(WSP(bf16_t, O_RK) + (size_t)t * 512 + h * 128 + 64 + seg * 8) = pack8(o2);
#pragma unroll
            for (int i = 0; i < 8; ++i) { tl[(seg * 8 + i) * 72 + tloc] = f2bf(o1[i] * kdec); tl[(64 + seg * 8 + i) * 72 + tloc] = f2bf(o2[i] * kdec); }
            __syncthreads();
            { const int d = tid >> 2, q4 = tid & 3; bf16_t* dst = WSP(bf16_t, O_RKDT) + (size_t)(h * 128 + d) * T + tt * 64 + q4 * 16;
              *(u32x4*)dst = *(const u32x4*)(tl + d * 72 + q4 * 16); *(u32x4*)(dst + 8) = *(const u32x4*)(tl + d * 72 + q4 * 16 + 8); }
            __syncthreads();
            { const u32x4 v1 = *(const u32x4*)(pr + 1024), v2 = *(const u32x4*)(pr + 1024 + 64);
              const bf16_t* a = (const bf16_t*)&v1; const bf16_t* b = (const bf16_t*)&v2;
#pragma unroll
              for (int i = 0; i < 8; ++i) { tl[(seg * 8 + i) * 72 + tloc] = a[i]; tl[(64 + seg * 8 + i) * 72 + tloc] = b[i]; } }
            __syncthreads();
            { const int d = tid >> 2, q4 = tid & 3; bf16_t* dst = WSP(bf16_t, O_RVT) + (size_t)(h * 128 + d) * T + tt * 64 + q4 * 16;
              *(u32x4*)dst = *(const u32x4*)(tl + d * 72 + q4 * 16); *(u32x4*)(dst + 8) = *(const u32x4*)(tl + d * 72 + q4 * 16 + 8); }
            __syncthreads();
        }
    }
}

__device__ __forceinline__ void phase_r1(const Params& p, int l) {
    const int tid = tid_(), G = gridDim.x;
    const bf16_t* P = WSP(bf16_t, O_P);
#pragma unroll 4
    for (int tp = blockIdx.x; tp < T / 2; tp += G) {
        const int j = tid & 255, t = tp * 2 + (tid >> 8); const int pc = PRW + 1536 + j;
        const bf16_t curb = P[(size_t)t * NINP + pc], prevb = P[(size_t)(t > 0 ? t - 1 : t) * NINP + pc];
        const float cur = bf2f(curb); const float prev = t > 0 ? bf2f(prevb) : 0.f;
        const float xs = cur + (prev - cur) * p.rwkv_mu[l * 1792 + 1536 + j];
        float o; if (j < 64) o = tanhf(xs); else if (j < 128) o = xs; else o = sigmoidf_(xs);
        WSP(bf16_t, O_LORAA)[(size_t)t * 256 + j] = f2bf(o);
    }
}


__device__ __forceinline__ void phase_mid(const Params& p, int l, unsigned char* lds, int b, int G) {
    LAS unsigned char* L = (LAS unsigned char*)lds;
    { pg8::Gemm g{WSP(bf16_t, O_CQN), WSP(bf16_t, O_WT_UQ), T, 768, 384, 384, 384, 0, 0}; pg8::Sched S; S.init(T, 768, G, b, 1);
      pg8::EpiBf16 E{WSP(bf16_t, O_QRAW), 768}; pg8::gemm_phase(L, g, S, E); }
    { pg8::Gemm g{WSP(bf16_t, O_CKVN), WSP(bf16_t, O_WT_UKV), T, 1024, 256, 256, 256, 0, 0}; pg8::Sched S; S.init(T, 1024, G, (b + G - (96 % G)) % G, 1);
      pg8::EpiBf16 E{WSP(bf16_t, O_KVRAW), 1024}; pg8::gemm_phase(L, g, S, E); }
    __syncthreads();
    if (b == G - 1) { const int c = tid_(); float carry = 0.f;
        for (int t0 = 0; t0 < 128; t0 += 32) { float av[32], hv[32];
#pragma unroll
            for (int i = 0; i < 32; ++i) { av[i] = WSP(float, O_TILEA)[(t0 + i) * 512 + c]; hv[i] = WSP(float, O_TILEH)[(t0 + i) * 512 + c]; }
            __builtin_amdgcn_sched_barrier(0);
#pragma unroll
            for (int i = 0; i < 32; ++i) { WSP(float, O_CARRY)[(t0 + i) * 512 + c] = carry; carry = av[i] * carry + hv[i]; } } }
    { const int tid = tid_(), w = tid >> 6, lane = tid & 63, fr = lane & 15, g4 = lane >> 4;
      const bf16_t* VT = WSP(bf16_t, O_RVT); const bf16_t* KD = WSP(bf16_t, O_RKDT); float* KV = WSP(float, O_RKV);
      for (int it = b; it < 256; it += G) { const int h = it >> 6, j = it & 63;
          f32x4 acc[8];
#pragma unroll
          for (int nb = 0; nb < 8; ++nb) acc[nb] = (f32x4){0.f, 0.f, 0.f, 0.f};
#pragma unroll
          for (int kp = 0; kp < 2; ++kp) {
              bf16x8 af[2], bfr[2][8];
#pragma unroll
              for (int k2 = 0; k2 < 2; ++k2) { const int t0 = j * 128 + (kp * 2 + k2) * 32 + g4 * 8;
                  af[k2] = *(const bf16x8*)(VT + (size_t)(h * 128 + w * 16 + fr) * T + t0);
#pragma unroll
                  for (int nb = 0; nb < 8; ++nb) bfr[k2][nb] = *(const bf16x8*)(KD + (size_t)(h * 128 + nb * 16 + fr) * T + t0); }
              __builtin_amdgcn_sched_barrier(0);
#pragma unroll
              for (int k2 = 0; k2 < 2; ++k2)
#pragma unroll
                  for (int nb = 0; nb < 8; ++nb) acc[nb] = __builtin_amdgcn_mfma_f32_16x16x32_bf16(af[k2], bfr[k2][nb], acc[nb], 0, 0, 0);
              __builtin_amdgcn_sched_barrier(0); }
          float* o = KV + ((size_t)(h * 64 + j) * 128) * 128;
#pragma unroll
          for (int nb = 0; nb < 8; ++nb)
#pragma unroll
              for (int jj = 0; jj < 4; ++jj) o[(w * 16 + g4 * 4 + jj) * 128 + nb * 16 + fr] = acc[nb][jj]; } }
}

__device__ __forceinline__ void phase_r3(const Params& p, int l) {
    const int tid = tid_(), w = tid >> 6, lane = tid & 63, G = gridDim.x;
    const bf16_t* P = WSP(bf16_t, O_P);
    { const int c = tid; const float mu_r = p.rwkv_mu[l * 1792 + c], mu_k = p.rwkv_mu[l * 1792 + 512 + c], mu_v = p.rwkv_mu[l * 1792 + 1024 + c];
      const float w0 = p.rwkv_w0[l * 512 + c], a0 = p.rwkv_a0[l * 512 + c], kk_ = p.rwkv_k_k[l * 512 + c], ka = p.rwkv_k_a[l * 512 + c], rk = p.rwkv_r_k[l * 512 + c];
      float* scan = WSP(float, O_SCAN); const bf16_t* lo = WSP(bf16_t, O_LORAO);
#pragma unroll 4
      for (int t = blockIdx.x; t < T; t += G) {
          const bf16_t* pc = P + (size_t)t * NINP + PRW + c; const bf16_t* pp = t > 0 ? pc - NINP : pc; const float pf = t > 0 ? 1.0f : 0.0f;
          const bf16_t r0b = pc[0], k0b = pc[512], v0b = pc[1024], r1b = pp[0], k1b = pp[512], v1b = pp[1024], lwb = lo[(size_t)t * 1536 + c], lab = lo[(size_t)t * 1536 + 512 + c];
          const float r0 = bf2f(r0b), k0 = bf2f(k0b), v0 = bf2f(v0b);
          const float r1 = bf2f(r1b) * pf, k1 = bf2f(k1b) * pf, v1 = bf2f(v1b) * pf;
          const float r = r0 + (r1 - r0) * mu_r, k = k0 + (k1 - k0) * mu_k, v = v0 + (v1 - v0) * mu_v;
          const float z = w0 + bf2f(lwb);
          const float wlog = -log1pf(__expf(-z)) - 0.5f; const float dec = __expf(-__expf(wlog));
          const float a = sigmoidf_(a0 + bf2f(lab));
          const float kkr = k * kk_; const float nrm = sqrtf(wave_sum(kkr * kkr)); const float kkn = kkr / fmaxf(nrm, 1e-12f);
          const float kp = k * (1.0f + (a - 1.0f) * ka); const float akk = kkn * a;
          const float c1 = wave_sum(akk * r), c2 = wave_sum(kp * r), bon = wave_sum(r * kp * rk);
          float* sb = scan + ((size_t)(t * 8 + w) * 5) * 64 + lane;
          sb[0] = dec; sb[64] = kp; { f32x2 nr = {-kkn, dec * r}; *(f32x2*)(sb + 128 + lane) = nr; } sb[256] = akk;
          WSP(float, O_RWV)[(size_t)t * 512 + c] = v;
          if (lane == 0) { f32x4 s = {c1 * 0.0625f, c2 * 0.0625f, bon, 0.f}; *(f32x4*)(WSP(float, O_RWS) + (size_t)(t * 8 + w) * 4) = s; }
      } }
}

__device__ __forceinline__ void phase_prep2(const Params& p, int l, unsigned char* lds, int bb, int G) {
    const int tid = tid_(), w = tid >> 6, lane = tid & 63;
    const bf16_t* P = WSP(bf16_t, O_P);
    { const float* cosm = WSP(float, O_COSM); const float* sinm = WSP(float, O_SINM);
      const float gq0 = p.mla_g_qn[l * 192 + lane], gq1 = p.mla_g_qn[l * 192 + 64 + lane], gq2 = p.mla_g_qn[l * 192 + 128 + lane];
      const float gk0 = p.mla_g_kn[l * 192 + lane], gk1 = p.mla_g_kn[l * 192 + 64 + lane], gk2 = p.mla_g_kn[l * 192 + 128 + lane];
      const float qsc = 0.07216878364870323f * 1.4426950408889634f;
#pragma unroll 2
      for (int tp = bb; tp < T / 2; tp += G) { const int t = tp * 2 + (w >> 2), h = w & 3;
          const float cs = cosm[t * 32 + (lane & 31)], sn = sinm[t * 32 + (lane & 31)];
          { const bf16_t* q = WSP(bf16_t, O_QRAW) + (size_t)t * 768 + h * 192;
            float a0 = bf2f(q[lane]), a1 = bf2f(q[64 + lane]), a2 = bf2f(q[128 + lane]);
            const float rs = rsqrtf(wave_sum(a0 * a0 + a1 * a1 + a2 * a2) * (1.0f / 192.0f) + 1e-6f);
            a0 *= rs * gq0; a1 *= rs * gq1; a2 *= rs * gq2;
            const float pa = __shfl_xor(a2, 32); const float ro = lane < 32 ? (a2 * cs - pa * sn) : (pa * sn + a2 * cs);
            bf16_t* qo = WSP(bf16_t, O_MQ) + ((size_t)h * T + t) * 192;
            qo[lane] = f2bf(a0 * qsc); qo[64 + lane] = f2bf(a1 * qsc); qo[128 + lane] = f2bf(ro * qsc); }
          { const bf16_t* kv = WSP(bf16_t, O_KVRAW) + (size_t)t * 1024 + h * 256;
            float a0 = bf2f(kv[lane]), a1 = bf2f(kv[64 + lane]), a2 = bf2f(P[(size_t)t * NINP + PKR + lane]);
            const float rs = rsqrtf(wave_sum(a0 * a0 + a1 * a1 + a2 * a2) * (1.0f / 192.0f) + 1e-6f);
            a0 *= rs * gk0; a1 *= rs * gk1; a2 *= rs * gk2;
            const float pa = __shfl_xor(a2, 32); const float ro = lane < 32 ? (a2 * cs - pa * sn) : (pa * sn + a2 * cs);
            bf16_t* ko = WSP(bf16_t, O_MK) + ((size_t)h * T + t) * 192;
            ko[lane] = f2bf(a0); ko[64 + lane] = f2bf(a1); ko[128 + lane] = f2bf(ro); }
      } }
    { bf16_t* tl = (bf16_t*)lds;
      for (int it = bb; it < 512; it += G) { const int tt = it >> 2, h = it & 3; const int tloc = tid >> 3, seg = tid & 7; const int t = tt * 64 + tloc;
          const bf16_t* src = WSP(bf16_t, O_KVRAW) + (size_t)t * 1024 + h * 256 + 128 + seg * 8;
          const u32x4 v1 = *(const u32x4*)src, v2 = *(const u32x4*)(src + 64);
          const bf16_t* a = (const bf16_t*)&v1; const bf16_t* bq = (const bf16_t*)&v2;
#pragma unroll
          for (int i = 0; i < 8; ++i) { tl[(seg * 8 + i) * 72 + tloc] = a[i]; tl[(64 + seg * 8 + i) * 72 + tloc] = bq[i]; }
          __syncthreads();
          { const int d = tid >> 2, q4 = tid & 3; bf16_t* dst = WSP(bf16_t, O_MVT) + (size_t)(h * 128 + d) * T + tt * 64 + q4 * 16;
            *(u32x4*)dst = *(const u32x4*)(tl + d * 72 + q4 * 16); *(u32x4*)(dst + 8) = *(const u32x4*)(tl + d * 72 + q4 * 16 + 8); }
          __syncthreads(); } }
    for (int e = bb * NTHR + tid; e < 4 * 16384; e += G * NTHR) { const int h = e >> 14, vd = e & 16383;
        const float cd = __expf(ret_lg(h) * 128.0f);
        const float* kv = WSP(float, O_RKV) + (size_t)h * 64 * 16384 + vd; bf16_t* sb = WSP(bf16_t, O_RSB) + (size_t)h * 64 * 16384 + vd; float s = 0.f;
        for (int i0 = 0; i0 < 64; i0 += 32) { float kvv[32];
#pragma unroll
            for (int i = 0; i < 32; ++i) kvv[i] = kv[(size_t)(i0 + i) * 16384];
            __builtin_amdgcn_sched_barrier(0);
#pragma unroll
            for (int i = 0; i < 32; ++i) { sb[(size_t)(i0 + i) * 16384] = f2bf(s); s = cd * s + kvv[i]; } } }
    for (int e = bb * NTHR + tid; e < T * 64; e += G * NTHR) { const int t = e >> 6, c = (e & 63) * 8;
        const float* cp = WSP(float, O_CARRY) + (t >> 6) * 512 + c; const float* hp = WSP(float, O_HLOC) + (size_t)t * 512 + c; const float* pp = WSP(float, O_PC) + (size_t)t * 512 + c;
        const f32x4 c0 = *(const f32x4*)cp, c1 = *(const f32x4*)(cp + 4), h0 = *(const f32x4*)hp, h1 = *(const f32x4*)(hp + 4), p0 = *(const f32x4*)pp, p1 = *(const f32x4*)(pp + 4);
        float g[8], r[8]; unpack8(*(const u32x4*)(P + (size_t)t * NINP + PAG + c), g);
#pragma unroll
        for (int i = 0; i < 8; ++i) { const float hv = i < 4 ? h0[i] + p0[i] * c0[i] : h1[i - 4] + p1[i - 4] * c1[i - 4]; const float gv = g[i];
            r[i] = hv * (gv * __builtin_amdgcn_rcpf(1.0f + __expf(-1.5957691216057308f * (gv + 0.044715f * gv * gv * gv)))); }
        *(u32x4*)(WSP(bf16_t, O_YS) + (size_t)t * D + c) = pack8(r); }
}

__device__ __forceinline__ void rwkv_scan(const Params& p, unsigned char* lds, int b) {
    const int tid = tid_(), w = tid >> 6, lane = tid & 63;
    const int h = b >> 2, rbase = (b & 3) * 16;
    constexpr int CH = 16, NC = T / CH, OV = CH * 1280, BUF = OV + CH * 16 * 8, PB0 = 2 * BUF, PBS = CH * 16 * 64;
    const unsigned char* gscan = (const unsigned char*)WSP(float, O_SCAN);
    const float* gv = WSP(float, O_RWV); const float* gs = WSP(float, O_RWS);
    if (w >= 4) {
        const int lt = tid - 256, step_l = lt >> 4, row_l = lt & 15;
        u32x4 R[2][5]; float Rv[2]; f32x4 Rs[2]; float vc2[2] = {0.f, 0.f};
        int pstep[5], poff[5];
#pragma unroll
        for (int i = 0; i < 5; ++i) { const int piece = lt + i * 256; pstep[i] = piece / 80; poff[i] = piece % 80; }
        float* ob = WSP(float, O_ORAW) + h * 64 + rbase + row_l;
#define SC_ISSUE(c, q) do { _Pragma("unroll") for (int i = 0; i < 5; ++i) R[q][i] = *(const u32x4*)(gscan + ((size_t)(((c) * CH + pstep[i]) * 8 + h)) * 1280 + poff[i] * 16); \
            Rv[q] = gv[(size_t)((c) * CH + step_l) * 512 + h * 64 + rbase + row_l]; Rs[q] = *(const f32x4*)(gs + (size_t)(((c) * CH + step_l) * 8 + h) * 4); } while (0)
#define SC_STORE(buf, q) do { unsigned char* bb = lds + (buf) * BUF; _Pragma("unroll") for (int i = 0; i < 5; ++i) *(u32x4*)(bb + pstep[i] * 1280 + poff[i] * 16) = R[q][i]; \
            { f32x2 vc = {Rv[q], Rs[q][0]}; *(f32x2*)(bb + OV + lt * 8) = vc; } vc2[q] = Rv[q] * Rs[q][1] * 16.0f; } while (0)
#define SC_REDUCE(cprev, q) do { const unsigned char* pb = lds + PB0 + ((cprev) & 1) * PBS + lt * 64; \
            const f32x4 a0 = *(const f32x4*)pb, a1 = *(const f32x4*)(pb + 16), a2 = *(const f32x4*)(pb + 32), a3 = *(const f32x4*)(pb + 48); \
            const f32x4 sm = (a0 + a1) + (a2 + a3); ob[(size_t)((cprev) * CH + step_l) * 512] = ((sm[0] + sm[1]) + (sm[2] + sm[3])) + vc2[q]; } while (0)
        SC_ISSUE(0, 0); SC_STORE(0, 0); SC_ISSUE(1, 1); SC_ISSUE(2, 0);
        __syncthreads();
        for (int c = 0; c < NC; c += 2) {
            if (c > 0) SC_REDUCE(c - 1, 1);
            SC_STORE(1, 1);
            if (c + 3 < NC) SC_ISSUE(c + 3, 1);
            __syncthreads();
            SC_REDUCE(c, 0);
            if (c + 2 < NC) SC_STORE(0, 0);
            if (c + 4 < NC) SC_ISSUE(c + 4, 0);
            __syncthreads();
        }
        SC_REDUCE(NC - 1, 1);
#undef SC_REDUCE
#undef SC_ISSUE
#undef SC_STORE
    } else {
        const int s = lane & 15, rl = w * 4 + (lane >> 4);
        f32x2 S01 = {0.f, 0.f}, S23 = {0.f, 0.f};
        __syncthreads();
        for (int c = 0; c < NC; ++c) {
            const unsigned char* bb = lds + (c & 1) * BUF;
            float* pb = (float*)(lds + PB0 + (c & 1) * PBS) + rl * 16 + s;
            f32x4 qw[2], qk[2], qx[2], qy[2], qa[2]; f32x2 qv[2];
#define SC_LD(j, st) do { const unsigned char* sp = bb + (st) * 1280 + s * 16; qw[j] = *(const f32x4*)(sp); qk[j] = *(const f32x4*)(sp + 256); \
                qx[j] = *(const f32x4*)(bb + (st) * 1280 + 512 + s * 32); qy[j] = *(const f32x4*)(bb + (st) * 1280 + 528 + s * 32); \
                qa[j] = *(const f32x4*)(sp + 1024); qv[j] = *(const f32x2*)(bb + OV + ((st) * 16 + rl) * 8); } while (0)
            SC_LD(0, 0);
#pragma unroll
            for (int st = 0; st < CH; ++st) {
                if (st + 1 < CH) SC_LD((st + 1) & 1, st + 1);
                const int j = st & 1;
                const float vv = qv[j][0];
                const f32x2 w01 = {qw[j][0], qw[j][1]}, w23 = {qw[j][2], qw[j][3]}, k01 = {qk[j][0], qk[j][1]}, k23 = {qk[j][2], qk[j][3]};
                const f32x2 a01 = {qa[j][0], qa[j][1]}, a23 = {qa[j][2], qa[j][3]};
                const f32x2 t01 = S01 * w01 + k01 * vv, t23 = S23 * w23 + k23 * vv;
                f32x2 de = (f32x2){S01[0], S01[0]} * (f32x2){qx[j][0], qx[j][1]};
                de += (f32x2){S01[1], S01[1]} * (f32x2){qx[j][2], qx[j][3]};
                de += (f32x2){S23[0], S23[0]} * (f32x2){qy[j][0], qy[j][1]};
                de += (f32x2){S23[1], S23[1]} * (f32x2){qy[j][2], qy[j][3]};
                const float sa = row16_sum(de[0]);
                pb[st * 256] = de[1] + sa * qv[j][1];
                S01 = a01 * sa + t01; S23 = a23 * sa + t23;
            }
#undef SC_LD
            __syncthreads();
        }
    }
}

__device__ __forceinline__ void attn_unit(const Params& p, unsigned char* lds, int h, int qb) {
    const int tid = tid_(), w = tid >> 6, lane = tid & 63, fr = lane & 15, g4 = lane >> 4, rg = w & 3, kh = w >> 2;
    const bf16_t* Q = WSP(bf16_t, O_MQ) + (size_t)h * T * 192; const bf16_t* K = WSP(bf16_t, O_MK) + (size_t)h * T * 192; const bf16_t* VT = WSP(bf16_t, O_MVT) + (size_t)h * 128 * T;
    constexpr int KSB = 64 * 400, VSB = 128 * 144, BUFB = KSB + VSB;
    const int qrow = qb * 64 + rg * 16 + fr;
    bf16x8 qf[6];
#pragma unroll
    for (int ks = 0; ks < 6; ++ks) qf[ks] = *(const bf16x8*)(Q + (size_t)qrow * 192 + ks * 32 + g4 * 8);
    f32x4 o[8];
#pragma unroll
    for (int vb = 0; vb < 8; ++vb) o[vb] = (f32x4){0.f, 0.f, 0.f, 0.f};
    float lsum = 0.f;
    u32x4 pkA[3], pvA[2], pkB[3], pvB[2];
    int krow[3], kcc[3];
#pragma unroll
    for (int i = 0; i < 3; ++i) { const int ci = tid + i * 512; krow[i] = ci / 24; kcc[i] = ci % 24; }
    const int vrow0 = tid >> 3, vcc = tid & 7;
#define ATT_LOAD(kt, pk, pv) do { _Pragma("unroll") for (int i = 0; i < 3; ++i) pk[i] = *(const u32x4*)(K + (size_t)((kt) * 64 + krow[i]) * 192 + kcc[i] * 8); \
        _Pragma("unroll") for (int i = 0; i < 2; ++i) pv[i] = *(const u32x4*)(VT + (size_t)(vrow0 + i * 64) * T + (kt) * 64 + vcc * 8); } while (0)
#define ATT_STORE(buf, pk, pv) do { unsigned char* bb = lds + (buf) * BUFB; _Pragma("unroll") for (int i = 0; i < 3; ++i) *(u32x4*)(bb + krow[i] * 400 + kcc[i] * 16) = pk[i]; \
        _Pragma("unroll") for (int i = 0; i < 2; ++i) *(u32x4*)(bb + KSB + (vrow0 + i * 64) * 144 + vcc * 16) = pv[i]; } while (0)
#define ATT_M0 24.0f
#define ATT_BODY(buf, kt) do { \
        const unsigned char* ks_ = lds + (buf) * BUFB; const unsigned char* vs_ = ks_ + KSB; \
        f32x4 s[2]; \
        _Pragma("unroll") for (int kb = 0; kb < 2; ++kb) { s[kb] = (f32x4){0.f, 0.f, 0.f, 0.f}; \
            _Pragma("unroll") for (int ks = 0; ks < 6; ++ks) { const bf16x8 kf = *(const bf16x8*)(ks_ + (kh * 32 + kb * 16 + fr) * 400 + (ks * 32 + g4 * 8) * 2); \
                s[kb] = __builtin_amdgcn_mfma_f32_16x16x32_bf16(kf, qf[ks], s[kb], 0, 0, 0); } } \
        float pe[8]; float ps = 0.f; \
        _Pragma("unroll") for (int kb = 0; kb < 2; ++kb) \
            _Pragma("unroll") for (int j = 0; j < 4; ++j) { float e = ex2(s[kb][j] - ATT_M0); \
                if ((kt) == qb) { const int key = (kt) * 64 + kh * 32 + kb * 16 + g4 * 4 + j; e = key > qrow ? 0.f : e; } pe[kb * 4 + j] = e; ps += e; } \
        lsum += ps; \
        const bf16x8 pf = as_bf16x8(pack8(pe)); \
        _Pragma("unroll") for (int vb = 0; vb < 8; ++vb) { const unsigned char* vr = vs_ + (vb * 16 + fr) * 144 + (kh * 32 + g4 * 4) * 2; \
            const u32x2 lo = *(const u32x2*)vr, hi = *(const u32x2*)(vr + 32); u32x4 vv; vv[0] = lo[0]; vv[1] = lo[1]; vv[2] = hi[0]; vv[3] = hi[1]; \
            o[vb] = __builtin_amdgcn_mfma_f32_16x16x32_bf16(as_bf16x8(vv), pf, o[vb], 0, 0, 0); } } while (0)
    ATT_LOAD(0, pkA, pvA); ATT_STORE(0, pkA, pvA);
    if (1 <= qb) ATT_LOAD(1, pkA, pvA);
    if (2 <= qb) ATT_LOAD(2, pkB, pvB);
    __syncthreads();
    for (int kt = 0; kt <= qb; kt += 2) {
        ATT_BODY(0, kt);
        if (kt + 1 <= qb) ATT_STORE(1, pkA, pvA);
        if (kt + 3 <= qb) ATT_LOAD(kt + 3, pkA, pvA);
        __syncthreads();
        if (kt + 1 > qb) break;
        ATT_BODY(1, kt + 1);
        if (kt + 2 <= qb) ATT_STORE(0, pkB, pvB);
        if (kt + 4 <= qb) ATT_LOAD(kt + 4, pkB, pvB);
        __syncthreads();
    }
#undef ATT_BODY
#undef ATT_LOAD
#undef ATT_STORE
    lsum += __shfl_xor(lsum, 16); lsum += __shfl_xor(lsum, 32);
    float* comb = (float*)(lds + 90112); float* mb = comb + 4 * 32 * 64; float* lb = mb + 256;
    if (kh == 1) {
#pragma unroll
        for (int vb = 0; vb < 8; ++vb)
#pragma unroll
            for (int j = 0; j < 4; ++j) comb[(rg * 32 + vb * 4 + j) * 64 + lane] = o[vb][j];
        lb[rg * 64 + lane] = lsum; }
    __syncthreads();
    if (kh == 0) { const float l1 = lb[rg * 64 + lane]; const float a0 = 1.0f, a1 = 1.0f;
        const float inv = 1.0f / (lsum + l1);
        bf16_t* yo = WSP(bf16_t, O_YS) + (size_t)qrow * D + 512 + h * 128 + g4 * 4;
#pragma unroll
        for (int vb = 0; vb < 8; ++vb) { float r[4];
#pragma unroll
            for (int j = 0; j < 4; ++j) r[j] = (o[vb][j] * a0 + comb[(rg * 32 + vb * 4 + j) * 64 + lane] * a1) * inv;
            u32x2 st; st[0] = pack2(r[0], r[1]); st[1] = pack2(r[2], r[3]); *(u32x2*)(yo + vb * 16) = st; } }
    __syncthreads();
}

__device__ __forceinline__ void ret_item(const Params& p, int l, unsigned char* lds, int h, int ci) {
    const int tid = tid_(), w = tid >> 6, lane = tid & 63, fr = lane & 15, g4 = lane >> 4;
    constexpr int RS = 272;
    unsigned char* Ks = lds; unsigned char* Vs = lds + 128 * RS; unsigned char* Ss = lds + 2 * 128 * RS;
    const bf16_t* RK = WSP(bf16_t, O_RK); const bf16_t* RVT = WSP(bf16_t, O_RVT); const bf16_t* SB = WSP(bf16_t, O_RSB) + (size_t)(h * 64 + ci) * 16384;
    { u32x4 tk[4], tv[4], ts[4];
#pragma unroll
      for (int i = 0; i < 4; ++i) { const int cidx = tid + i * 512, row = cidx >> 4, cc = cidx & 15;
          tk[i] = *(const u32x4*)(RK + (size_t)(ci * 128 + row) * 512 + h * 128 + cc * 8);
          tv[i] = *(const u32x4*)(RVT + (size_t)(h * 128 + row) * T + ci * 128 + cc * 8);
          ts[i] = *(const u32x4*)(SB + row * 128 + cc * 8); }
      __builtin_amdgcn_sched_barrier(0);
#pragma unroll
      for (int i = 0; i < 4; ++i) { const int cidx = tid + i * 512, row = cidx >> 4, cc = cidx & 15;
          *(u32x4*)(Ks + row * RS + cc * 16) = tk[i]; *(u32x4*)(Vs + row * RS + cc * 16) = tv[i]; *(u32x4*)(Ss + row * RS + cc * 16) = ts[i]; } }
    const int ql = w * 16 + fr, t = ci * 128 + ql;
    bf16x8 qf[4];
#pragma unroll
    for (int ks = 0; ks < 4; ++ks) qf[ks] = *(const bf16x8*)(WSP(bf16_t, O_RQ) + (size_t)t * 512 + h * 128 + ks * 32 + g4 * 8);
    __syncthreads();
    const float lg2 = ret_lg(h) * 1.4426950408889634f;
    f32x4 o[8], cr[8];
#pragma unroll
    for (int vb = 0; vb < 8; ++vb) { o[vb] = (f32x4){0.f, 0.f, 0.f, 0.f}; cr[vb] = (f32x4){0.f, 0.f, 0.f, 0.f}; }
#pragma unroll
    for (int kp = 0; kp < 4; ++kp) {
        float pe[8];
#pragma unroll
        for (int hb = 0; hb < 2; ++hb) { const int kb = kp * 2 + hb; f32x4 s = {0.f, 0.f, 0.f, 0.f};
#pragma unroll
            for (int ks = 0; ks < 4; ++ks) { const bf16x8 kf = *(const bf16x8*)(Ks + (kb * 16 + fr) * RS + (ks * 32 + g4 * 8) * 2);
                s = __builtin_amdgcn_mfma_f32_16x16x32_bf16(kf, qf[ks], s, 0, 0, 0); }
#pragma unroll
            for (int j = 0; j < 4; ++j) { const int rel = ql - (kb * 16 + g4 * 4 + j); pe[hb * 4 + j] = rel >= 0 ? s[j] * ex2(lg2 * (float)rel) : 0.f; } }
        const bf16x8 pf = as_bf16x8(pack8(pe));
#pragma unroll
        for (int vb = 0; vb < 8; ++vb) { const unsigned char* vr = Vs + (vb * 16 + fr) * RS + (kp * 32 + g4 * 4) * 2;
            const u32x2 lo = *(const u32x2*)vr, hi = *(const u32x2*)(vr + 32); u32x4 vv; vv[0] = lo[0]; vv[1] = lo[1]; vv[2] = hi[0]; vv[3] = hi[1];
            o[vb] = __builtin_amdgcn_mfma_f32_16x16x32_bf16(as_bf16x8(vv), pf, o[vb], 0, 0, 0); }
    }
#pragma unroll
    for (int vb = 0; vb < 8; ++vb)
#pragma unroll
        for (int ks = 0; ks < 4; ++ks) { const bf16x8 sf = *(const bf16x8*)(Ss + (vb * 16 + fr) * RS + (ks * 32 + g4 * 8) * 2);
            cr[vb] = __builtin_amdgcn_mfma_f32_16x16x32_bf16(sf, qf[ks], cr[vb], 0, 0, 0); }
    const bf16_t* gp = WSP(bf16_t, O_P) + (size_t)t * NINP + PRET + 1536 + h * 128 + g4 * 4;
    const float* gn = p.ret_g_norm + l * 512 + h * 128 + g4 * 4;
    u32x2 gul[8]; f32x4 gnl[8];
#pragma unroll
    for (int vb = 0; vb < 8; ++vb) { gul[vb] = *(const u32x2*)(gp + vb * 16); gnl[vb] = *(const f32x4*)(gn + vb * 16); }
    __builtin_amdgcn_sched_barrier(0);
    const float qdec = ex2(lg2 * (float)(ql + 1));
    float sum = 0.f;
#pragma unroll
    for (int vb = 0; vb < 8; ++vb) { o[vb] += qdec * cr[vb]; sum += o[vb][0] + o[vb][1] + o[vb][2] + o[vb][3]; }
    sum += __shfl_xor(sum, 16); sum += __shfl_xor(sum, 32); const float mean = sum * (1.0f / 128.0f);
    float var = 0.f;
#pragma unroll
    for (int vb = 0; vb < 8; ++vb)
#pragma unroll
        for (int j = 0; j < 4; ++j) { const float d = o[vb][j] - mean; o[vb][j] = d; var += d * d; }
    var += __shfl_xor(var, 16); var += __shfl_xor(var, 32); const float rstd = rsqrtf(var * (1.0f / 128.0f) + 1e-5f);
    bf16_t* yo = WSP(bf16_t, O_YS) + (size_t)t * D + 1024 + h * 128 + g4 * 4;
#pragma unroll
    for (int vb = 0; vb < 8; ++vb) { const u32x2 gu = gul[vb]; const f32x4 gnv = gnl[vb];
        const float gt[4] = {bflo(gu[0]), bfhi(gu[0]), bflo(gu[1]), bfhi(gu[1])}; float r[4];
#pragma unroll
        for (int j = 0; j < 4; ++j) r[j] = o[vb][j] * rstd * gnv[j] * (gt[j] * __builtin_amdgcn_rcpf(1.0f + __expf(-gt[j])));
        u32x2 st; st[0] = pack2(r[0], r[1]); st[1] = pack2(r[2], r[3]); *(u32x2*)(yo + vb * 16) = st; }
    __syncthreads();
}

__device__ __forceinline__ void rwkv_fin_head(const Params& p, int l, int b, unsigned* cnt) {
    const int tid = tid_(), h = b >> 2, q = b & 3;
    asm volatile("s_waitcnt vmcnt(0)" ::: "memory");
    __syncthreads();
    if (tid == 0) {
        __builtin_amdgcn_fence(__ATOMIC_RELEASE, "agent");
        asm volatile("s_waitcnt vmcnt(0)" ::: "memory");
        (void)__hip_atomic_fetch_add(cnt, 1u, __ATOMIC_RELAXED, __HIP_MEMORY_SCOPE_AGENT);
        unsigned sp = 0;
        while (__hip_atomic_load(cnt, __ATOMIC_RELAXED, __HIP_MEMORY_SCOPE_AGENT) < 4u) { __builtin_amdgcn_s_sleep(2); if (++sp > (1u << 22)) break; }
        __builtin_amdgcn_fence(__ATOMIC_ACQUIRE, "agent");
        asm volatile("s_waitcnt vmcnt(0)" ::: "memory");
    }
    __syncthreads();
    __builtin_amdgcn_fence(__ATOMIC_ACQUIRE, "agent");
    asm volatile("s_waitcnt vmcnt(0)" ::: "memory");
    const int tl = tid >> 3, sub = tid & 7, ch = h * 64 + sub * 8;
    const f32x4 gn0 = *(const f32x4*)(p.rwkv_g_norm + l * 512 + ch), gn1 = *(const f32x4*)(p.rwkv_g_norm + l * 512 + ch + 4);
#pragma unroll 2
    for (int it = 0; it < 32; ++it) { const int t = q * 2048 + it * 64 + tl;
        const float* op = WSP(float, O_ORAW) + (size_t)t * 512 + ch; const float* vp = WSP(float, O_RWV) + (size_t)t * 512 + ch;
        const f32x4 o0 = *(const f32x4*)op, o1 = *(const f32x4*)(op + 4), v0 = *(const f32x4*)vp, v1 = *(const f32x4*)(vp + 4);
        float g[8]; unpack8(*(const u32x4*)(WSP(bf16_t, O_LORAO) + (size_t)t * 1536 + 1024 + ch), g);
        const float bon = WSP(float, O_RWS)[(size_t)(t * 8 + h) * 4 + 2];
        float x[8] = {o0[0], o0[1], o0[2], o0[3], o1[0], o1[1], o1[2], o1[3]};
        float sm = 0.f;
#pragma unroll
        for (int i = 0; i < 8; ++i) sm += x[i];
        const float mean = row8_sum(sm) * (1.0f / 64.0f);
        float vs = 0.f;
#pragma unroll
        for (int i = 0; i < 8; ++i) { x[i] -= mean; vs += x[i] * x[i]; }
        const float rstd = rsqrtf(row8_sum(vs) * (1.0f / 64.0f) + 1e-5f);
        float r[8];
#pragma unroll
        for (int i = 0; i < 8; ++i) { const float gnv = i < 4 ? gn0[i] : gn1[i - 4]; const float vv = i < 4 ? v0[i] : v1[i - 4]; r[i] = (x[i] * rstd * gnv + bon * vv) * g[i]; }
        *(u32x4*)(WSP(bf16_t, O_YS) + (size_t)t * D + 1536 + ch) = pack8(r); }
}

__device__ __forceinline__ void phase_big(const Params& p, int l, unsigned char* lds, const XcdBarrier& xs) {
    const int b = bid_(), G = gridDim.x;
    constexpr int XS = 160;
    if (b < 32) { rwkv_scan(p, lds, b); rwkv_fin_head(p, l, b, (unsigned*)(p.ws + O_BAR) + 3456 + (l * 8 + (b >> 2)) * 32);
                  __syncthreads(); phase_convert(p, l, lds, CONV_N0, CONV_N0 + XS, false, b, 32); return; }
    const int bb = b - 32, GG = G - 32;
    { pg8::Gemm g{WSP(bf16_t, O_HBUF), WSP(bf16_t, O_WT_IN), T, G1B_N, D, D, D, 0, 0}; pg8::Sched S; S.init(T, G1B_N, GG, bb, 1);
      pg8::EpiBf16 E{WSP(bf16_t, O_P), NINP}; pg8::gemm_phase((LAS unsigned char*)lds, g, S, E); }
    __syncthreads();
    phase_convert(p, l, lds, CONV_N0 + XS, CONV_NBIG, false, bb, GG);
    xcd_barrier(xs);
    if (l == 0) phase_convert(p, 1, lds, 0, CONV_N0, false, bb, GG);
    __syncthreads();
    phase_prep1(p, l, lds, bb, GG);
    xcd_barrier(xs);
    phase_mid(p, l, lds, bb, GG);
    xcd_barrier(xs);
    phase_prep2(p, l, lds, bb, GG);
    xcd_barrier(xs);
#pragma nounroll
    for (int k = 0; k * GG < 512; ++k) { const int r = (k & 1) ? k * GG + (GG - 1 - bb) : k * GG + bb;
        if (r < 512) attn_unit(p, lds, r & 3, 127 - (r >> 2)); }
    { const int n3 = 512 - 2 * GG > 0 ? 512 - 2 * GG : 0; const int nf = GG - n3 > 0 ? GG - n3 : GG; const int j = bb - n3;
      if (j >= 0) for (int it = j; it < 256; it += nf) ret_item(p, l, lds, it >> 6, it & 63);
      else if (nf == GG) for (int it = bb; it < 256; it += GG) ret_item(p, l, lds, it >> 6, it & 63); }
}

__device__ __forceinline__ void phase_rwkvfin(const Params& p, int l) {
    const int tid = tid_(), w = tid >> 6;
    const float gn = p.rwkv_g_norm[l * 512 + tid];
#pragma unroll 4
    for (int t = blockIdx.x; t < T; t += gridDim.x) {
        const float o = WSP(float, O_ORAW)[(size_t)t * 512 + tid];
        const float mean = wave_sum(o) * (1.0f / 64.0f); const float d = o - mean; const float var = wave_sum(d * d) * (1.0f / 64.0f);
        const float bon = WSP(float, O_RWS)[(size_t)(t * 8 + w) * 4 + 2];
        const float y = (d * rsqrtf(var + 1e-5f) * gn + bon * WSP(float, O_RWV)[(size_t)t * 512 + tid]) * bf2f(WSP(bf16_t, O_LORAO)[(size_t)t * 1536 + 1024 + tid]);
        WSP(bf16_t, O_YS)[(size_t)t * D + 1536 + tid] = f2bf(y);
    }
}

constexpr int NPHASE = 23;
__global__ void __launch_bounds__(512, 2) fwd_kernel(Params pk, int lo, int hi) {
    extern __shared__ __attribute__((aligned(16))) unsigned char shm[];
    LAS unsigned char* L = (LAS unsigned char*)shm;
    const int G = gridDim.x;
    volatile LAS unsigned* xst = (volatile LAS unsigned*)(L + 131072);
    if (threadIdx.x == 0) { xst[0] = 0u; xst[1] = 0u; xst[2] = 0u; xst[3] = 0u; }
    __syncthreads();
    XcdBarrier xb = xcd_barrier_post((unsigned*)(pk.ws + O_BAR), xst, (unsigned)G);
    XcdBarrier xs; xs.total = (unsigned)(G - 32); xs.bar = (unsigned*)(pk.ws + O_BAR) + 4096; xs.x = xb.x; xs.st = xst + 2;
    if (blockIdx.x >= 32) xs = xcd_barrier_post((unsigned*)(pk.ws + O_BAR) + 4096, xst + 2, (unsigned)(G - 32));
    for (int ph = lo; ph < hi; ++ph) {
        const int b = bid_();
        Params p = pk; { unsigned long long v = (unsigned long long)pk.ws; asm volatile("" : "+s"(v)); p.ws = (unsigned char*)(__attribute__((address_space(1))) unsigned char*)v; }
        if (ph == 0) { phase_init(p, shm); phase_convert(p, 0, shm, 0, CONV_N0, true, b, G); }
        else {
            const int l = (ph - 1) / 11, s0 = (ph - 1) % 11; const int s = s0 < 6 ? s0 : s0 + 1;
            const float* mod = WSP(float, O_MOD) + l * 6 * D;
            const float* xcur = l == 0 ? p.x : WSP(float, O_XRES);
            switch (s) {
            case 0: if (l == 1) phase_convert(p, 1, shm, 0, 0, true, b, G);
                    phase_norm(p, xcur, p.norm_mix + l * D, mod + D, mod); break;
            case 1: { pg8::Gemm g{WSP(bf16_t, O_HBUF), WSP(bf16_t, O_WT_IN) + (size_t)G1B_N * D, T, NINP - G1B_N, D, D, D, 0, 0}; pg8::Sched S; S.init(T, NINP - G1B_N, G, b, 1);
                      pg8::EpiBf16 E{WSP(bf16_t, O_P) + G1B_N, NINP}; pg8::gemm_phase(L, g, S, E); } break;
            case 2: phase_r1(p, l); break;
            case 3: { pg8::Gemm g{WSP(bf16_t, O_LORAA), WSP(bf16_t, O_WT_LORA), T, 1536, 256, 256, 256, 0, 0}; pg8::Sched S; S.init(T, 1536, G, b, 1);
                      pg8::EpiBf16 E{WSP(bf16_t, O_LORAO), 1536}; pg8::gemm_phase(L, g, S, E); } break;
            case 4: phase_r3(p, l); break;
            case 5: phase_big(p, l, shm, xs); break;
            case 6: phase_rwkvfin(p, l); break;
            case 7: { pg8::Gemm g{WSP(bf16_t, O_YS), WSP(bf16_t, O_WT_BR), T, D, 512, D, 512, (size_t)512 * 2, (size_t)D * 512 * 2}; pg8::Sched S; S.init(T, D, G, b, 4);
                      pg8::EpiGate E{WSP(bf16_t, O_P), WSP(bf16_t, O_HBUF)}; pg8::gemm_phase(L, g, S, E); } break;
            case 8: { pg8::Gemm g{WSP(bf16_t, O_HBUF), WSP(bf16_t, O_WT_OUT), T, D, D, D, D, 0, 0}; pg8::Sched S; S.init(T, D, G, b, 1);
                      pg8::EpiRes E{xcur, WSP(float, O_XRES), mod + 2 * D}; pg8::gemm_phase(L, g, S, E); } break;
            case 9: phase_norm(p, WSP(float, O_XRES), p.norm_ffn + l * D, mod + 4 * D, mod + 3 * D); break;
            case 10: { pg8::Gemm g{WSP(bf16_t, O_HBUF), WSP(bf16_t, O_WT_FFI), T, 2 * FF, D, D, D, 0, 0}; pg8::Sched S; S.init(T, 2 * FF, G, b, 1);
                       pg8::EpiSwiGLU E{WSP(bf16_t, O_P)}; pg8::gemm_phase(L, g, S, E); } break;
            case 11: { pg8::Gemm g{WSP(bf16_t, O_P), WSP(bf16_t, O_WT_FFO), T, D, FF, FF, FF, 0, 0}; pg8::Sched S; S.init(T, D, G, b, 1);
                       pg8::EpiRes E{WSP(float, O_XRES), l == 1 ? p.out : WSP(float, O_XRES), mod + 5 * D}; pg8::gemm_phase(L, g, S, E); } break;
            default: break;
            }
        }
        if (ph + 1 < hi) { if (hi < 0) cg::this_grid().sync(); else xcd_barrier(xb); }
    }
}

extern "C" void kernel_launch(void* const* d_in, const int* in_sizes, int n_in, void* d_out, int out_size, void* d_ws, size_t ws_size, hipStream_t stream) {
    static int grid_blocks = 0;
    if (!grid_blocks) {
        hipFuncSetAttribute((const void*)fwd_kernel, hipFuncAttributeMaxDynamicSharedMemorySize, LDS_BYTES);
        int dev = 0, cus = 0, per_cu = 0;
        hipGetDevice(&dev);
        hipDeviceGetAttribute(&cus, hipDeviceAttributeMultiprocessorCount, dev);
        hipOccupancyMaxActiveBlocksPerMultiprocessor(&per_cu, fwd_kernel, NTHR, LDS_BYTES);
        if (per_cu < 1) per_cu = 1;
        grid_blocks = cus * (per_cu > 1 ? 1 : per_cu);
    }
    if (ws_size < O_END) { fprintf(stderr, "workspace too small: %zu < %zu\n", ws_size, (size_t)O_END); }
    Params p{};
    p.x = (const float*)d_in[0]; p.c = (const float*)d_in[1]; p.pos = (const int*)d_in[2];
    const float** fp = &p.ada_w;
    for (int i = 0; i < 33; ++i) fp[i] = (const float*)d_in[3 + i];
    p.out = (float*)d_out; p.ws = (unsigned char*)d_ws;
#if COOP
    hipMemsetAsync((unsigned char*)d_ws + O_BAR, 0, 8192 * 4, stream);
    int lo = 0, hi = NPHASE;
    void* args[] = {&p, &lo, &hi};
    hipError_t e = hipLaunchCooperativeKernel((const void*)fwd_kernel, dim3(grid_blocks), dim3(NTHR), args, LDS_BYTES, stream);
    if (e != hipSuccess) fprintf(stderr, "cooperative launch failed: %s (grid %d)\n", hipGetErrorString(e), grid_blocks);
#else
    for (int ph = 0; ph < NPHASE; ++ph) hipLaunchKernelGGL(fwd_kernel, dim3(grid_blocks), dim3(NTHR), LDS_BYTES, stream, p, ph, ph + 1);
#endif
}
```
